# Optimizing an MI355X kernel written in HIP

```python
import jax
import jax.numpy as jnp
from jax import lax
import numpy as np

D_MODEL = 1024
BATCH = 4
SEQ = 8192
DEPTH = 2

HEAD_DIM = 64
ROT_DIM = HEAD_DIM // 4
ROPE_THETA = 500000.0
BLOCK = 128
RMS_EPS = 1e-6
LN_EPS = 1e-5

A_HEADS = (D_MODEL // 2) // HEAD_DIM
A_KV_HEADS = 2
A_WINDOW = 128
CONV_CH = D_MODEL // 2
CONV_WIDTH = 31
C_HEADS = (D_MODEL // 2) // HEAD_DIM
DILATED_PAIRS = ((128, 1), (512, 4), (2048, 16))
D_CH = D_MODEL // 2
D_GROUPS = D_CH // HEAD_DIM
CHUNK = 128
D_FF = ((8 * D_MODEL // 3 + 255) // 256) * 256

A_Q = A_HEADS * HEAD_DIM
A_KV = A_KV_HEADS * HEAD_DIM
EVEN_IN = A_Q + 2 * A_KV + 2 * CONV_CH
EVEN_OUT = A_Q + CONV_CH
C_W = C_HEADS * HEAD_DIM
ODD_IN = 3 * C_W + 2 * D_CH
ODD_OUT = C_W + D_CH
N_EVEN = (DEPTH + 1) // 2
N_ODD = DEPTH // 2

kernel_name = 'hybrid_swa_sink_conformer_dilated_gmlp'


def rms_norm(x, g):
    xf = x.astype(jnp.float32)
    y = xf * lax.rsqrt(jnp.mean(xf * xf, axis=-1, keepdims=True) + RMS_EPS)
    return (y * g.astype(jnp.float32)).astype(x.dtype)


def layer_norm(x, g, b):
    xf = x.astype(jnp.float32)
    mu = jnp.mean(xf, axis=-1, keepdims=True)
    xc = xf - mu
    var = jnp.mean(xc * xc, axis=-1, keepdims=True)
    y = xc * lax.rsqrt(var + LN_EPS) * g.astype(jnp.float32) + b.astype(jnp.float32)
    return y.astype(x.dtype)


def rotary(x, pos):
    half = ROT_DIM // 2
    inv_freq = ROPE_THETA ** (-jnp.arange(half, dtype=jnp.float32) * (2.0 / ROT_DIM))
    ang = pos.astype(jnp.float32)[:, None] * inv_freq[None, :]
    cos = jnp.cos(ang)[None, :, None, :]
    sin = jnp.sin(ang)[None, :, None, :]
    xr = x[..., :ROT_DIM].astype(jnp.float32)
    x1, x2 = xr[..., :half], xr[..., half:]
    rot = jnp.concatenate([x1 * cos - x2 * sin, x2 * cos + x1 * sin], axis=-1).astype(x.dtype)
    return jnp.concatenate([rot, x[..., ROT_DIM:]], axis=-1)


def band_attention(q, k, v, max_dist, sink=None):
    B, S, Hq, hd = q.shape
    Hkv = k.shape[2]
    G = Hq // Hkv
    n = S // BLOCK
    qb = q.reshape(B, n, BLOCK, Hkv, G, hd)
    kb = k.reshape(B, n, BLOCK, Hkv, hd)
    vb = v.reshape(B, n, BLOCK, Hkv, hd)
    prev = lambda t: jnp.pad(t, ((0, 0), (1, 0), (0, 0), (0, 0), (0, 0)))[:, :-1]
    kk = jnp.concatenate([prev(kb), kb], axis=2)
    vv = jnp.concatenate([prev(vb), vb], axis=2)
    s = jnp.einsum('bnqhgd,bnjhd->bnhgqj', qb, kk,
                   preferred_element_type=jnp.float32) * (hd ** -0.5)
    qi = jnp.arange(BLOCK)[:, None]
    kj = jnp.arange(2 * BLOCK)[None, :]
    dist = qi + BLOCK - kj
    key_pos = jnp.arange(n)[:, None, None] * BLOCK + kj[None] - BLOCK
    valid = (dist >= 0)[None] & (dist <= max_dist)[None] & (key_pos >= 0)
    s = jnp.where(valid[None, :, None, None], s, -jnp.inf)
    m = jnp.max(s, axis=-1)
    if sink is not None:
        sink_b = sink.astype(jnp.float32).reshape(Hkv, G)[None, None, :, :, None]
        m = jnp.maximum(m, sink_b)
    p = jnp.exp(s - m[..., None])
    l = jnp.sum(p, axis=-1)
    if sink is not None:
        l = l + jnp.exp(sink_b - m)
    o = jnp.einsum('bnhgqj,bnjhd->bnqhgd', p.astype(v.dtype), vv,
                   preferred_element_type=jnp.float32)
    o = o / jnp.transpose(l, (0, 1, 4, 2, 3))[..., None]
    lse = jnp.transpose(m + jnp.log(l), (0, 1, 4, 2, 3)).reshape(B, S, Hq)
    return o.reshape(B, S, Hq, hd).astype(q.dtype), lse


def dilated_window_attention(q, k, v, window, dilation):
    B, S, H, hd = q.shape
    span = dilation * BLOCK
    s_pad = -(-S // span) * span
    sub = s_pad // dilation

    def fold(t):
        t = jnp.pad(t, ((0, 0), (0, s_pad - S), (0, 0), (0, 0)))
        t = t.reshape(B, sub, dilation, t.shape[2], hd)
        return jnp.transpose(t, (0, 2, 1, 3, 4)).reshape(B * dilation, sub, t.shape[3], hd)

    o, lse = band_attention(fold(q), fold(k), fold(v), window // dilation)
    o = jnp.transpose(o.reshape(B, dilation, sub, H, hd), (0, 2, 1, 3, 4)).reshape(B, s_pad, H, hd)
    lse = jnp.transpose(lse.reshape(B, dilation, sub, H), (0, 2, 1, 3)).reshape(B, s_pad, H)
    return o[:, :S], lse[:, :S]


def causal_depthwise_conv(x, w, b):
    C = x.shape[-1]
    y = lax.conv_general_dilated(
        x, w[:, None, :].astype(x.dtype), window_strides=(1,),
        padding=[(CONV_WIDTH - 1, 0)], dimension_numbers=('NWC', 'WIO', 'NWC'),
        feature_group_count=C)
    return y + b.astype(x.dtype)


def even_mixer(h, w_in, sinks, conv_w, conv_b, ln_g, ln_b, w_out, pos):
    B, S, _ = h.shape
    proj = jnp.einsum('bsd,de->bse', h, w_in)
    q, k, v, glu = jnp.split(proj, [A_Q, A_Q + A_KV, A_Q + 2 * A_KV], axis=-1)
    q = rotary(q.reshape(B, S, A_HEADS, HEAD_DIM), pos)
    k = rotary(k.reshape(B, S, A_KV_HEADS, HEAD_DIM), pos)
    v = v.reshape(B, S, A_KV_HEADS, HEAD_DIM)
    a, _ = band_attention(q, k, v, A_WINDOW - 1, sinks)
    a = a.reshape(B, S, A_Q)
    g_a, g_b = jnp.split(glu, 2, axis=-1)
    c = g_a * jax.nn.sigmoid(g_b)
    c = causal_depthwise_conv(c, conv_w, conv_b)
    c = jax.nn.silu(layer_norm(c, ln_g, ln_b))
    return jnp.einsum('bse,ed->bsd', jnp.concatenate([a, c], axis=-1), w_out)


def odd_mixer(h, w_in, sgu_ln_g, sgu_ln_b, spatial_w, spatial_b, w_out, pos):
    B, S, _ = h.shape
    proj = jnp.einsum('bsd,de->bse', h, w_in)
    q, k, v, z = jnp.split(proj, [C_W, 2 * C_W, 3 * C_W], axis=-1)
    q = rotary(q.reshape(B, S, C_HEADS, HEAD_DIM), pos)
    k = rotary(k.reshape(B, S, C_HEADS, HEAD_DIM), pos)
    v = v.reshape(B, S, C_HEADS, HEAD_DIM)
    outs, lses = [], []
    for window, dilation in DILATED_PAIRS:
        o_r, lse_r = dilated_window_attention(q, k, v, window, dilation)
        outs.append(o_r)
        lses.append(lse_r)
    alpha = jax.nn.softmax(jnp.stack(lses, axis=0), axis=0)
    c_out = jnp.einsum('rbsh,rbshd->bshd', alpha, jnp.stack(outs, axis=0).astype(jnp.float32))
    c_out = c_out.astype(h.dtype).reshape(B, S, C_W)
    z = jax.nn.gelu(z)
    u, g = jnp.split(z, 2, axis=-1)
    g = layer_norm(g, sgu_ln_g, sgu_ln_b).reshape(B, S // CHUNK, CHUNK, D_GROUPS, HEAD_DIM)
    causal = jnp.tril(jnp.ones((CHUNK, CHUNK), dtype=bool))
    w_s = jnp.where(causal[None], spatial_w, 0).astype(g.dtype)
    mixed = jnp.einsum('gts,bcsgd->bctgd', w_s, g) + spatial_b.T.astype(g.dtype)[None, None, :, :, None]
    d_out = u * mixed.reshape(B, S, D_CH)
    return jnp.einsum('bse,ed->bsd', jnp.concatenate([c_out, d_out], axis=-1), w_out)


def swiglu(h, w_gate, w_up, w_down):
    gate = jnp.einsum('bsd,df->bsf', h, w_gate)
    up = jnp.einsum('bsd,df->bsf', h, w_up)
    return jnp.einsum('bsf,fd->bsd', jax.nn.silu(gate) * up, w_down)


def setup_inputs(seed: int = 0) -> dict:
    key = jax.random.key(seed)
    ks = jax.random.split(key, 21)
    f32 = jnp.float32

    def nrm(k, shape, scale):
        return jax.random.normal(k, shape, f32) * scale

    return {
        'x': nrm(ks[0], (BATCH, SEQ, D_MODEL), 1.0),
        'ev_norm_g': 1.0 + nrm(ks[1], (N_EVEN, D_MODEL), 0.02),
        'ev_w_in': nrm(ks[2], (N_EVEN, D_MODEL, EVEN_IN), D_MODEL ** -0.5),
        'ev_sinks': nrm(ks[3], (N_EVEN, A_HEADS), 0.5),
        'ev_conv_w': nrm(ks[4], (N_EVEN, CONV_WIDTH, CONV_CH), CONV_WIDTH ** -0.5),
        'ev_conv_b': nrm(ks[5], (N_EVEN, CONV_CH), 0.02),
        'ev_conv_ln_g': 1.0 + nrm(ks[6], (N_EVEN, CONV_CH), 0.02),
        'ev_conv_ln_b': nrm(ks[7], (N_EVEN, CONV_CH), 0.02),
        'ev_w_out': nrm(ks[8], (N_EVEN, EVEN_OUT, D_MODEL), EVEN_OUT ** -0.5),
        'od_norm_g': 1.0 + nrm(ks[9], (N_ODD, D_MODEL), 0.02),
        'od_w_in': nrm(ks[10], (N_ODD, D_MODEL, ODD_IN), D_MODEL ** -0.5),
        'od_sgu_ln_g': 1.0 + nrm(ks[11], (N_ODD, D_CH), 0.02),
        'od_sgu_ln_b': nrm(ks[12], (N_ODD, D_CH), 0.02),
        'od_spatial_w': nrm(ks[13], (N_ODD, D_GROUPS, CHUNK, CHUNK), CHUNK ** -0.5),
        'od_spatial_b': 1.0 + nrm(ks[14], (N_ODD, D_GROUPS, CHUNK), 0.02),
        'od_w_out': nrm(ks[15], (N_ODD, ODD_OUT, D_MODEL), ODD_OUT ** -0.5),
        'ffn_norm_g': 1.0 + nrm(ks[16], (DEPTH, D_MODEL), 0.02),
        'ffn_w_gate': nrm(ks[17], (DEPTH, D_MODEL, D_FF), D_MODEL ** -0.5),
        'ffn_w_up': nrm(ks[18], (DEPTH, D_MODEL, D_FF), D_MODEL ** -0.5),
        'ffn_w_down': nrm(ks[19], (DEPTH, D_FF, D_MODEL), D_FF ** -0.5),
        'final_norm_g': 1.0 + nrm(ks[20], (D_MODEL,), 0.02),
    }


def reference(x, ev_norm_g, ev_w_in, ev_sinks, ev_conv_w, ev_conv_b, ev_conv_ln_g,
              ev_conv_ln_b, ev_w_out, od_norm_g, od_w_in, od_sgu_ln_g, od_sgu_ln_b,
              od_spatial_w, od_spatial_b, od_w_out, ffn_norm_g, ffn_w_gate, ffn_w_up,
              ffn_w_down, final_norm_g):
    pos = jnp.arange(x.shape[1], dtype=jnp.int32)
    h = x
    for layer in range(DEPTH):
        i = layer // 2
        if layer % 2 == 0:
            h = h + even_mixer(rms_norm(h, ev_norm_g[i]), ev_w_in[i], ev_sinks[i],
                               ev_conv_w[i], ev_conv_b[i], ev_conv_ln_g[i],
                               ev_conv_ln_b[i], ev_w_out[i], pos)
        else:
            h = h + odd_mixer(rms_norm(h, od_norm_g[i]), od_w_in[i], od_sgu_ln_g[i],
                              od_sgu_ln_b[i], od_spatial_w[i], od_spatial_b[i],
                              od_w_out[i], pos)
        h = h + swiglu(rms_norm(h, ffn_norm_g[layer]), ffn_w_gate[layer],
                       ffn_w_up[layer], ffn_w_down[layer])
    return rms_norm(h, final_norm_g)
```

```cpp
#include <hip/hip_runtime.h>
#include <hip/hip_cooperative_groups.h>
#include <cstdio>
#include <cstdint>
namespace cg = cooperative_groups;

#define LAS __attribute__((address_space(3)))
typedef unsigned short bf16_t;
typedef short bf16x8 __attribute__((ext_vector_type(8)));
typedef short s16x4 __attribute__((ext_vector_type(4)));
typedef float f32x4 __attribute__((ext_vector_type(4)));
typedef float f32x2 __attribute__((ext_vector_type(2)));
typedef float f32x16 __attribute__((ext_vector_type(16)));
typedef unsigned u32x4 __attribute__((ext_vector_type(4)));
typedef unsigned u32x2 __attribute__((ext_vector_type(2)));

constexpr int M = 32768, DM = 1024, SEQ = 8192, DFF = 2816, E_IN = 1792, O_IN = 2560;
constexpr int NTHR = 512, NWAVE = 8;
constexpr float LOG2E = 1.4426950408889634f;
constexpr float QK_C2 = 0.125f * LOG2E;

constexpr size_t KiB = 1024, MiB = 1024 * 1024;
constexpr size_t WS_BAR = 512 * KiB, BAR_BYTES = 16 * KiB;
constexpr size_t WS_COS = 0, WS_SIN = 256 * KiB, WS_SPW = 1 * MiB, WS_SS = 2 * MiB;
constexpr size_t WS_W_EIN = 4 * MiB, WS_W_EOUT = WS_W_EIN + 3584 * KiB, WS_W_GU0 = WS_W_EOUT + 2 * MiB, WS_W_GU1 = WS_W_GU0 + 11 * MiB;
constexpr size_t WS_W_DN0 = WS_W_GU1 + 11 * MiB, WS_W_DN1 = WS_W_DN0 + 5632 * KiB, WS_W_OIN = WS_W_DN1 + 5632 * KiB, WS_W_OOUT = WS_W_OIN + 5 * MiB;
constexpr size_t WS_R1 = 50 * MiB;
constexpr size_t WS_CE = WS_R1 + 48 * MiB;
constexpr size_t WS_MIX = 226 * MiB, WS_HB = 290 * MiB, WS_OB = 354 * MiB, WS_LSE = 450 * MiB, WS_END = 453 * MiB;
static_assert(WS_W_OOUT + 2 * MiB <= WS_R1, "weights fit");

constexpr int LDS_BYTES = 147456;

struct Params { const float* in[21]; float* out; unsigned char* ws; };

__device__ __forceinline__ unsigned f2bf(float f) { unsigned u = __builtin_bit_cast(unsigned, f); return (u + 0x7fffu + ((u >> 16) & 1u)) >> 16; }
typedef __bf16 bf16x2_t __attribute__((ext_vector_type(2)));
__device__ __forceinline__ unsigned pk2(float lo, float hi) { const f32x2 v = {lo, hi}; const bf16x2_t b = __builtin_convertvector(v, bf16x2_t); return __builtin_bit_cast(unsigned, b); }
__device__ __forceinline__ float bf2f(unsigned short b) { return __builtin_bit_cast(float, (unsigned)b << 16); }
__device__ __forceinline__ float bflo(unsigned w) { return __builtin_bit_cast(float, w << 16); }
__device__ __forceinline__ float bfhi(unsigned w) { return __builtin_bit_cast(float, w & 0xffff0000u); }
__device__ __forceinline__ int crow(int r, int hi) { return (r & 3) + 8 * (r >> 2) + 4 * hi; }
__device__ __forceinline__ float wave_sum(float v) {
#pragma unroll
    for (int o = 1; o < 64; o <<= 1) v += __shfl_xor(v, o);
    return v;
}
__device__ __forceinline__ float sigmoidf_(float x) { return __builtin_amdgcn_rcpf(1.f + __builtin_amdgcn_exp2f(-x * LOG2E)); }
__device__ __forceinline__ float siluf_(float x) { return x * sigmoidf_(x); }
__device__ __forceinline__ float gelu_tanh(float x) {
    const float y = 0.7978845608028654f * (x + 0.044715f * x * x * x);
    const float t = __builtin_amdgcn_exp2f(2.f * LOG2E * y);
    const float th = 1.f - 2.f * __builtin_amdgcn_rcpf(t + 1.f);
    return 0.5f * x * (1.f + th);
}
__device__ __forceinline__ float row_rstd(const float* ss, int row) {
    const f32x4* p = (const f32x4*)(ss + (size_t)row * 16);
    f32x4 a = p[0], b = p[1], c = p[2], d = p[3];
    const float s = ((a.x + a.y) + (a.z + a.w)) + ((b.x + b.y) + (b.z + b.w)) + ((c.x + c.y) + (c.z + c.w)) + ((d.x + d.y) + (d.z + d.w));
    return 1.0f / sqrtf(s * (1.0f / 1024.0f) + 1e-6f);
}

__device__ __forceinline__ void p0_transpose_item(const float* W, int ldn, int K, int k0, int srccol, const float* g, bf16_t* WT, int dstrow, LAS float* scr, int lane) {
    { f32x4 v[8]; const int c4 = (lane & 7) * 4;
#pragma unroll
      for (int i = 0; i < 8; ++i) v[i] = __builtin_nontemporal_load((const f32x4*)(W + (size_t)(k0 + 8 * i + (lane >> 3)) * ldn + srccol + c4));
#pragma unroll
      for (int i = 0; i < 8; ++i) { const int kk = 8 * i + (lane >> 3); const float gs = g ? g[k0 + kk] : 1.f; LAS float* d = scr + kk * 33 + c4; d[0] = v[i].x * gs; d[1] = v[i].y * gs; d[2] = v[i].z * gs; d[3] = v[i].w * gs; } }
    asm volatile("s_waitcnt lgkmcnt(0)" ::: "memory");
    const int c = lane & 7;
#pragma unroll
    for (int j = 0; j < 4; ++j) { const int n = (lane >> 3) + 8 * j; const LAS float* s = scr + (8 * c) * 33 + n;
        u32x4 o; o.x = pk2(s[0 * 33], s[1 * 33]); o.y = pk2(s[2 * 33], s[3 * 33]); o.z = pk2(s[4 * 33], s[5 * 33]); o.w = pk2(s[6 * 33], s[7 * 33]);
        __builtin_nontemporal_store(o, (u32x4*)(WT + (size_t)(dstrow + n) * K + k0 + 8 * c)); }
    asm volatile("s_waitcnt lgkmcnt(0)" ::: "memory");
}
constexpr int I_EIN = 16 * 56, I_EOUT = 16 * 32, I_GU = 16 * 176, I_DN = 44 * 32, I_OIN = 16 * 80, I_OOUT = 16 * 32;
constexpr int NITEMS = I_EIN + I_EOUT + 2 * I_GU + 2 * I_DN + I_OIN + I_OOUT;
constexpr int CONV_SPLIT = 7500;
__device__ __forceinline__ void convert_weights(const Params& P, LAS unsigned char* lds, int it0, int it1, int wk, int nwk) {
    int tid = threadIdx.x; asm volatile("" : "+v"(tid));
    const int lane = tid & 63, wave = tid >> 6;
    LAS float* scr = (LAS float*)(lds + wave * 16384);
    unsigned char* ws = P.ws;
    for (int it = it0 + wk; it < it1; it += nwk) {
        int r = it;
        if (r < I_EIN) { const int nb = r % 56, kb = r / 56; int src;
            if (nb < 24) src = 32 * nb; else { const int q = nb - 24, p = q >> 3, w = q & 7; src = 768 + (w >> 2) * 512 + 128 * p + (w & 3) * 32; }
            p0_transpose_item(P.in[2], E_IN, DM, 64 * kb, src, P.in[1], (bf16_t*)(ws + WS_W_EIN), 32 * nb, scr, lane); continue; }
        r -= I_EIN;
        if (r < I_EOUT) { const int nb = r % 32, kb = r / 32; p0_transpose_item(P.in[8], DM, DM, 64 * kb, 32 * nb, nullptr, (bf16_t*)(ws + WS_W_EOUT), 32 * nb, scr, lane); continue; }
        r -= I_EOUT;
        if (r < 2 * I_GU) { const int L = r / I_GU; r -= L * I_GU; const int nb = r % 176, kb = r / 176, p = nb >> 3, w = nb & 7;
            const float* src = ((w >> 2) ? P.in[18] : P.in[17]) + (size_t)L * DM * DFF;
            p0_transpose_item(src, DFF, DM, 64 * kb, 128 * p + (w & 3) * 32, P.in[16] + L * DM, (bf16_t*)(ws + (L ? WS_W_GU1 : WS_W_GU0)), 32 * nb, scr, lane); continue; }
        r -= 2 * I_GU;
        if (r < 2 * I_DN) { const int L = r / I_DN; r -= L * I_DN; const int nb = r % 32, kb = r / 32;
            p0_transpose_item(P.in[19] + (size_t)L * DFF * DM, DM, DFF, 64 * kb, 32 * nb, nullptr, (bf16_t*)(ws + (L ? WS_W_DN1 : WS_W_DN0)), 32 * nb, scr, lane); continue; }
        r -= 2 * I_DN;
        if (r < I_OIN) { const int nb = r % 80, kb = r / 80; p0_transpose_item(P.in[10], O_IN, DM, 64 * kb, 32 * nb, P.in[9], (bf16_t*)(ws + WS_W_OIN), 32 * nb, scr, lane); continue; }
        r -= I_OIN;
        { const int nb = r % 32, kb = r / 32; p0_transpose_item(P.in[15], DM, DM, 64 * kb, 32 * nb, nullptr, (bf16_t*)(ws + WS_W_OOUT), 32 * nb, scr, lane); }
    }
}
__device__ __forceinline__ void p0_prologue(const Params& P, LAS unsigned char* lds) {
    int tid = threadIdx.x; asm volatile("" : "+v"(tid));
    const int lane = tid & 63, wave = tid >> 6;
    const int gw = blockIdx.x * NWAVE + wave, NGW = gridDim.x * NWAVE;
    unsigned char* ws = P.ws;
    convert_weights(P, lds, 0, CONV_SPLIT, gw, NGW);
    const int gt = blockIdx.x * NTHR + tid, NGT = gridDim.x * NTHR;
    for (int i = gt; i < SEQ * 8; i += NGT) { const int pos = i >> 3, f = i & 7;
        const float inv = (float)pow(500000.0, -(double)f * 0.125); const float ang = (float)pos * inv;
        ((float*)(ws + WS_COS))[i] = (float)cos((double)ang); ((float*)(ws + WS_SIN))[i] = (float)sin((double)ang); }
    for (int i = gt; i < 8 * 128 * 128; i += NGT) { const int s = i & 127, t = (i >> 7) & 127; ((bf16_t*)(ws + WS_SPW))[i] = (s <= t) ? (bf16_t)f2bf(P.in[13][i]) : (bf16_t)0; }
    const float* x = P.in[0]; bf16_t* HB = (bf16_t*)(ws + WS_HB); float* SS = (float*)(ws + WS_SS);
    for (int m0 = gw * 4; m0 < M; m0 += NGW * 4) {
        f32x4 v[4][4];
#pragma unroll
        for (int r = 0; r < 4; ++r)
#pragma unroll
            for (int j = 0; j < 4; ++j) v[r][j] = __builtin_nontemporal_load((const f32x4*)(x + (size_t)(m0 + r) * DM) + lane + 64 * j);
#pragma unroll
        for (int r = 0; r < 4; ++r) { float s = 0.f; unsigned long long* o8 = (unsigned long long*)(HB + (size_t)(m0 + r) * DM) + lane;
#pragma unroll
            for (int j = 0; j < 4; ++j) { const f32x4 t = v[r][j]; s += (t.x * t.x + t.y * t.y) + (t.z * t.z + t.w * t.w);
                o8[64 * j] = (unsigned long long)pk2(t.x, t.y) | ((unsigned long long)pk2(t.z, t.w) << 32); }
            s = wave_sum(s);
            if (lane < 16) SS[(size_t)(m0 + r) * 16 + lane] = (lane == 0) ? s : 0.f; }
    }
}

namespace pg8 {
#define PG8_LAS __attribute__((address_space(3)))
constexpr int BM = 256, BK = 64, HALF = 128, HTB = HALF * BK * 2  , STAGE_BYTES = 8 * HTB, NXCD = 8, WGM = 8;

__host__ __device__ __forceinline__ int lds_byte(int r, int c) { const int st = (r >> 4) * 2 + (c >> 5), rr = r & 15, cc = c & 31, ob = rr * 64 + cc * 2; return st * 1024 + (ob ^ (((ob >> 9) & 1) << 5)); }
__host__ __device__ __forceinline__ void stage_rc(int b, int& R, int& C) { const int st = b / 1024, sb = b % 1024, swz = sb ^ (((sb >> 9) & 1) << 5); R = (st >> 1) * 16 + swz / 64; C = (st & 1) * 32 + (swz % 64) / 2; }
__host__ __device__ __forceinline__ int perm32(int rho) { const int n = rho >> 4, i = rho & 15; return 8 * (i >> 2) + 4 * n + (i & 3); }

struct Unit { int pm, pn; };
struct Gemm { const bf16_t* A; const bf16_t* Bt; int M, N, K; };

struct StaticOrder {
    int nM, nN, nwg, G, c;
    __host__ __device__ void init(int M, int N, int G_, int c_) { nM = M / BM; nN = N / BM; nwg = nM * nN; G = G_; c = c_; }
    __host__ __device__ bool next(int i, Unit& u) const {
        const long L = (long)i * G + c; if (L >= nwg) return false;
        int wgid = (int)L; { const int q = nwg / NXCD, r = nwg % NXCD, xcd = wgid % NXCD, off = wgid / NXCD; wgid = (xcd < r ? xcd * (q + 1) : r * (q + 1) + (xcd - r) * q) + off; }
        const int nig = WGM * nN, gid = wgid / nig, fm = gid * WGM, gsz = (nM - fm) < WGM ? (nM - fm) : WGM;
        u.pm = fm + ((wgid % nig) % gsz); u.pn = (wgid % nig) / gsz; return true;
    }
    __device__ __forceinline__ void a_ready(const Unit&) const {}
    __device__ __forceinline__ void done(const Unit&) const {}
};
constexpr int RSL_OFF = STAGE_BYTES;
template <class Sched> __device__ __forceinline__ void rs_precompute(const float* ss, const Sched& S, PG8_LAS unsigned char* lds) {
    int tid = threadIdx.x; asm volatile("" : "+v"(tid));
    PG8_LAS float* rsl = (PG8_LAS float*)(lds + RSL_OFF); Unit u;
    for (int i = tid >> 8; S.next(i, u); i += 2) { const int r = tid & 255; const f32x4* p = (const f32x4*)(ss + (size_t)(u.pm * BM + r) * 16);
        const f32x4 a = p[0], b = p[1], c = p[2], d = p[3];
        const float s = ((a.x + a.y) + (a.z + a.w)) + ((b.x + b.y) + (b.z + b.w)) + ((c.x + c.y) + (c.z + c.w)) + ((d.x + d.y) + (d.z + d.w));
        rsl[i * 256 + r] = __builtin_amdgcn_rsqf(s * (1.0f / 1024.0f) + 1e-6f); }
    __syncthreads();
}
template <bool HIN_F32> struct EpiRes {
    static constexpr bool PERM = true, AFTER_DRAIN = false;
    const float* hin32; bf16_t* hb; float* ssout;
    __device__ __forceinline__ void operator()(const f32x4 (&acc)[2][2][4][2], const Unit& u, int wr, int wc, int fr, int fq, int ui) const {
        const int col0 = u.pn * BM + wc * 32 + 8 * fq;
#pragma unroll
        for (int ai = 0; ai < 2; ++ai)
#pragma unroll
            for (int m = 0; m < 4; ++m) { const int row = u.pm * BM + ai * HALF + wr * 64 + m * 16 + fr; const size_t off = (size_t)row * DM + col0; float sq = 0.f;
#pragma unroll
                for (int bj = 0; bj < 2; ++bj) { const size_t o2 = off + bj * HALF; f32x4 h0, h1;
                    if (HIN_F32) { h0 = *(const f32x4*)(hin32 + o2); h1 = *(const f32x4*)(hin32 + o2 + 4); }
                    else { const u32x4 w = *(const u32x4*)(hb + o2); h0 = (f32x4){bflo(w.x), bfhi(w.x), bflo(w.y), bfhi(w.y)}; h1 = (f32x4){bflo(w.z), bfhi(w.z), bflo(w.w), bfhi(w.w)}; }
                    const f32x4 a = h0 + acc[ai][bj][m][0], b = h1 + acc[ai][bj][m][1];
                    u32x4 w; w.x = pk2(a[0], a[1]); w.y = pk2(a[2], a[3]); w.z = pk2(b[0], b[1]); w.w = pk2(b[2], b[3]); __builtin_nontemporal_store(w, (u32x4*)(hb + o2));
                    sq += ((a[0] * a[0] + a[1] * a[1]) + (a[2] * a[2] + a[3] * a[3])) + ((b[0] * b[0] + b[1] * b[1]) + (b[2] * b[2] + b[3] * b[3])); }
                sq += __shfl_xor(sq, 16); sq += __shfl_xor(sq, 32);
                if (fq == 0) ssout[(size_t)row * 16 + u.pn * 4 + wc] = sq;
                if (m & 1) asm volatile("" ::: "memory"); }
    }
};
struct EpiGU {
    static constexpr bool PERM = true, AFTER_DRAIN = false;
    PG8_LAS const float* rsl; bf16_t* hid;
    __device__ __forceinline__ void operator()(const f32x4 (&acc)[2][2][4][2], const Unit& u, int wr, int wc, int fr, int fq, int ui) const {
        const int col = u.pn * HALF + wc * 32 + 8 * fq;
#pragma unroll
        for (int ai = 0; ai < 2; ++ai)
#pragma unroll
            for (int m = 0; m < 4; ++m) { const int rl = ai * HALF + wr * 64 + m * 16 + fr; const int row = u.pm * BM + rl; const float rs = rsl[ui * 256 + rl]; const float c = -LOG2E * rs, rs2 = rs * rs;
                u32x4 w; unsigned* wp = (unsigned*)&w;
#pragma unroll
                for (int n = 0; n < 2; ++n) { const f32x4 g = acc[ai][0][m][n], up = acc[ai][1][m][n]; f32x4 e = g * c;
                    e[0] = __builtin_amdgcn_exp2f(e[0]); e[1] = __builtin_amdgcn_exp2f(e[1]); e[2] = __builtin_amdgcn_exp2f(e[2]); e[3] = __builtin_amdgcn_exp2f(e[3]);
                    e = e + 1.0f; f32x4 r; r[0] = __builtin_amdgcn_rcpf(e[0]); r[1] = __builtin_amdgcn_rcpf(e[1]); r[2] = __builtin_amdgcn_rcpf(e[2]); r[3] = __builtin_amdgcn_rcpf(e[3]);
                    const f32x4 o = (g * up) * (r * rs2); wp[2 * n] = pk2(o[0], o[1]); wp[2 * n + 1] = pk2(o[2], o[3]); }
                __builtin_nontemporal_store(w, (u32x4*)(hid + (size_t)row * DFF + col)); }
    }
};
template <int LAYER> struct EpiIn {
    static constexpr bool PERM = true, AFTER_DRAIN = false;
    PG8_LAS const float* rsl; const float* cosT; const float* sinT; bf16_t* o0; bf16_t* o1;
    __device__ __forceinline__ void operator()(const f32x4 (&acc)[2][2][4][2], const Unit& u, int wr, int wc, int fr, int fq, int ui) const {
        const int col0 = u.pn * BM + wc * 32 + 8 * fq;
#pragma unroll
        for (int ai = 0; ai < 2; ++ai)
#pragma unroll
            for (int m = 0; m < 4; ++m) { const int rl = ai * HALF + wr * 64 + m * 16 + fr; const int row = u.pm * BM + rl; const float rs = rsl[ui * 256 + rl];
                if (LAYER == 0 && u.pn >= 3) {
                    const f32x4 a0 = acc[ai][0][m][0] * rs, a1 = acc[ai][0][m][1] * rs, b0 = acc[ai][1][m][0] * rs, b1 = acc[ai][1][m][1] * rs;
                    u32x4 w; w.x = pk2(a0[0] * sigmoidf_(b0[0]), a0[1] * sigmoidf_(b0[1])); w.y = pk2(a0[2] * sigmoidf_(b0[2]), a0[3] * sigmoidf_(b0[3]));
                    w.z = pk2(a1[0] * sigmoidf_(b1[0]), a1[1] * sigmoidf_(b1[1])); w.w = pk2(a1[2] * sigmoidf_(b1[2]), a1[3] * sigmoidf_(b1[3]));
                    __builtin_nontemporal_store(w, (u32x4*)(o1 + (size_t)row * 512 + (u.pn - 3) * HALF + wc * 32 + 8 * fq));
                } else {
                    constexpr int ld = (LAYER == 0) ? 768 : O_IN;
#pragma unroll
                    for (int bj = 0; bj < 2; ++bj) { f32x4 v0 = acc[ai][bj][m][0] * rs, v1 = acc[ai][bj][m][1] * rs;
                        const bool rot = ((wc & 1) == 0) && ((LAYER == 0) ? (u.pn * BM + bj * HALF + wc * 32 < 640) : (u.pn < 4));
                        if (rot) { f32x4 p0, p1;
#pragma unroll
                            for (int j = 0; j < 4; ++j) { p0[j] = __shfl_xor(v0[j], 16); p1[j] = __shfl_xor(v1[j], 16); }
                            if (fq < 2) { const int pos = row & (SEQ - 1); const f32x4 c0 = *(const f32x4*)(cosT + pos * 8), c1 = *(const f32x4*)(cosT + pos * 8 + 4), s0 = *(const f32x4*)(sinT + pos * 8), s1 = *(const f32x4*)(sinT + pos * 8 + 4);
                                if (fq == 0) { v0 = v0 * c0 - p0 * s0; v1 = v1 * c1 - p1 * s1; } else { v0 = v0 * c0 + p0 * s0; v1 = v1 * c1 + p1 * s1; } } }
                        if (LAYER == 1 && u.pn >= 6) {
#pragma unroll
                            for (int j = 0; j < 4; ++j) { v0[j] = gelu_tanh(v0[j]); v1[j] = gelu_tanh(v1[j]); } }
                        u32x4 w; w.x = pk2(v0[0], v0[1]); w.y = pk2(v0[2], v0[3]); w.z = pk2(v1[0], v1[1]); w.w = pk2(v1[2], v1[3]);
                        __builtin_nontemporal_store(w, (u32x4*)(o0 + (size_t)row * ld + col0 + bj * HALF)); }
                } }
    }
};
template <class Epi, class Sched, bool ALIGN_EPI = false, bool SP2 = false>
__device__ __forceinline__ void gemm_phase(PG8_LAS unsigned char* lds, const Gemm g, const Sched& S, const Epi& E) {
    int tid = threadIdx.x; asm volatile("" : "+v"(tid));
    const int wid = __builtin_amdgcn_readfirstlane(tid >> 6), lane = tid & 63, wr = wid >> 2, wc = wid & 3, fr = lane & 15, fq = lane >> 4;
    const int K = g.K, nt = K / BK;
    unsigned voffA[2], voffB[2];
#pragma unroll
    for (int i = 0; i < 2; ++i) { int R, C; stage_rc(tid * 16 + i * 8192, R, C); const int Rb = Epi::PERM ? ((R & ~31) + perm32(R & 31)) : R;
        voffA[i] = (unsigned)(R * K + C) * 2u; voffB[i] = (unsigned)(Rb * K + C) * 2u; }
    const size_t kstep = (size_t)(BK * 2);
    const size_t hstep = (size_t)HALF * K * 2;
    const size_t tstep = 2 * hstep;
    const unsigned ldsw = (unsigned)wid * 1024u;
    const int aoff = lds_byte(wr * 64 + fr, fq * 8), boff = lds_byte(wc * 32 + fr, fq * 8);
#define PG8_SA(b, h) (((b) * 2 + (h)) * HTB)
#define PG8_SB(b, h) ((4 + (b) * 2 + (h)) * HTB)
#define PG8_STAGE(bufoff, gbase, voff) do { _Pragma("unroll") for (int _i = 0; _i < 2; ++_i) \
        __builtin_amdgcn_global_load_lds((const unsigned*)((const char*)(gbase) + (voff)[_i]), (PG8_LAS unsigned*)(lds + (bufoff) + ldsw + _i * 8192), 16, 0, 0); } while (0)
#define PG8_LDA(dst, b, h) do { _Pragma("unroll") for (int m = 0; m < 4; ++m) _Pragma("unroll") for (int k = 0; k < 2; ++k) dst[m][k] = *(const PG8_LAS bf16x8*)(lds + PG8_SA(b, h) + aoff + m * 2048 + k * 1024); } while (0)
#define PG8_LDB(dst, b, h) do { _Pragma("unroll") for (int n = 0; n < 2; ++n) _Pragma("unroll") for (int k = 0; k < 2; ++k) dst[n][k] = *(const PG8_LAS bf16x8*)(lds + PG8_SB(b, h) + boff + n * 2048 + k * 1024); } while (0)
#define PG8_MMA(ai, bj, At, Bt) do { __builtin_amdgcn_s_setprio(1); _Pragma("unroll") for (int m = 0; m < 4; ++m) _Pragma("unroll") for (int n = 0; n < 2; ++n) _Pragma("unroll") for (int k = 0; k < 2; ++k) \
        acc[ai][bj][m][n] = __builtin_amdgcn_mfma_f32_16x16x32_bf16(Bt[n][k], At[m][k], acc[ai][bj][m][n], 0, 0, 0); __builtin_amdgcn_s_setprio(0); } while (0)
#define PG8_WAIT_V(n) asm volatile("s_waitcnt vmcnt(" #n ")" ::: "memory")
#define PG8_WAIT_L(n) asm volatile("s_waitcnt lgkmcnt(" #n ")" ::: "memory")
#define PG8_BAR __builtin_amdgcn_s_barrier()
#define PG8_SCHED __builtin_amdgcn_sched_barrier(0)
    Unit cur, nxt; int ui = 0;
    if (!S.next(0, cur)) return;
    f32x4 acc[2][2][4][2];
#pragma unroll
    for (int a = 0; a < 2; ++a)
#pragma unroll
        for (int b = 0; b < 2; ++b)
#pragma unroll
            for (int m = 0; m < 4; ++m)
#pragma unroll
                for (int n = 0; n < 2; ++n) acc[a][b][m][n] = (f32x4){0.f, 0.f, 0.f, 0.f};
    bf16x8 At[4][2], B0[2][2], B1[2][2];
    const char* cA = (const char*)g.A + (size_t)cur.pm * tstep; const char* cB = (const char*)g.Bt + (size_t)cur.pn * tstep;
    S.a_ready(cur);
    if constexpr (SP2) {
        PG8_STAGE(PG8_SB(0, 0), cB, voffB); PG8_STAGE(PG8_SB(0, 1), cB + hstep, voffB); PG8_STAGE(PG8_SA(0, 0), cA, voffA); PG8_STAGE(PG8_SA(0, 1), cA + hstep, voffA);
        if (wr == 1) PG8_BAR;
        PG8_WAIT_V(2); PG8_BAR;
        PG8_STAGE(PG8_SB(1, 0), cB + kstep, voffB); PG8_STAGE(PG8_SA(1, 0), cA + kstep, voffA); PG8_STAGE(PG8_SB(1, 1), cB + hstep + kstep, voffB);
        PG8_WAIT_V(6); PG8_BAR;
    } else {
        PG8_STAGE(PG8_SB(0, 0), cB, voffB); PG8_STAGE(PG8_SA(0, 0), cA, voffA); PG8_STAGE(PG8_SB(0, 1), cB + hstep, voffB); PG8_STAGE(PG8_SA(0, 1), cA + hstep, voffA);
        if (wr == 1) PG8_BAR;
        PG8_WAIT_V(4); PG8_BAR;
        PG8_STAGE(PG8_SB(1, 0), cB + kstep, voffB); PG8_STAGE(PG8_SA(1, 0), cA + kstep, voffA); PG8_STAGE(PG8_SB(1, 1), cB + hstep + kstep, voffB);
        PG8_WAIT_V(6); PG8_BAR;
    }
    for (;;) {
        const bool has_next = S.next(ui + 1, nxt);
        const char* nA = has_next ? (const char*)g.A + (size_t)nxt.pm * tstep : cA; const char* nB = has_next ? (const char*)g.Bt + (size_t)nxt.pn * tstep : cB;
        for (int t = 0; t < nt; t += 2) {
            const bool last = (t == nt - 2);
            const char* a1 = cA + (size_t)(t + 1) * kstep;
            const char* a2 = last ? nA : cA + (size_t)(t + 2) * kstep; const char* b2 = last ? nB : cB + (size_t)(t + 2) * kstep;
            const char* a3 = a2 + kstep; const char* b3 = b2 + kstep;
            if (last && has_next) S.a_ready(nxt);
            if constexpr (SP2) {
            PG8_LDB(B0, 0, 0); PG8_LDB(B1, 0, 1); PG8_SCHED; PG8_LDA(At, 0, 0); PG8_STAGE(PG8_SA(1, 1), a1 + hstep, voffA);
            PG8_WAIT_V(8); PG8_WAIT_L(0); PG8_BAR; PG8_MMA(0, 0, At, B0); PG8_MMA(0, 1, At, B1); PG8_BAR; PG8_SCHED;
            PG8_LDA(At, 0, 1); PG8_STAGE(PG8_SB(0, 0), b2, voffB); PG8_STAGE(PG8_SB(0, 1), b2 + hstep, voffB); PG8_STAGE(PG8_SA(0, 0), a2, voffA);
            PG8_WAIT_V(8); PG8_WAIT_L(0); PG8_BAR; PG8_MMA(1, 0, At, B0); PG8_MMA(1, 1, At, B1); PG8_BAR; PG8_SCHED;
            PG8_LDB(B0, 1, 0); PG8_LDB(B1, 1, 1); PG8_SCHED; PG8_LDA(At, 1, 0); PG8_STAGE(PG8_SA(0, 1), a2 + hstep, voffA);
            PG8_WAIT_V(8); PG8_WAIT_L(0); PG8_BAR; PG8_MMA(0, 0, At, B0); PG8_MMA(0, 1, At, B1); PG8_BAR; PG8_SCHED;
            PG8_LDA(At, 1, 1); PG8_STAGE(PG8_SB(1, 0), b3, voffB); PG8_STAGE(PG8_SB(1, 1), b3 + hstep, voffB); PG8_STAGE(PG8_SA(1, 0), a3, voffA);
            PG8_WAIT_V(8); PG8_WAIT_L(0); PG8_BAR; PG8_MMA(1, 0, At, B0); PG8_MMA(1, 1, At, B1); PG8_BAR; PG8_SCHED;
            } else {
            PG8_LDB(B0, 0, 0); PG8_SCHED; PG8_LDA(At, 0, 0); PG8_STAGE(PG8_SA(1, 1), a1 + hstep, voffA);
            PG8_WAIT_L(8); PG8_BAR; PG8_WAIT_L(0); PG8_MMA(0, 0, At, B0); PG8_BAR; PG8_SCHED;
            PG8_LDB(B1, 0, 1); PG8_STAGE(PG8_SB(0, 0), b2, voffB);
            PG8_BAR; PG8_WAIT_L(0); PG8_MMA(0, 1, At, B1); PG8_BAR;
            PG8_LDA(At, 0, 1); PG8_STAGE(PG8_SA(0, 0), a2, voffA);
            PG8_BAR; PG8_WAIT_L(0); PG8_MMA(1, 0, At, B0); PG8_BAR; PG8_SCHED;
            PG8_STAGE(PG8_SB(0, 1), b2 + hstep, voffB);
            PG8_WAIT_V(6); PG8_BAR; PG8_MMA(1, 1, At, B1); PG8_BAR;
            PG8_LDB(B0, 1, 0); PG8_SCHED; PG8_LDA(At, 1, 0); PG8_STAGE(PG8_SA(0, 1), a2 + hstep, voffA);
            PG8_WAIT_L(8); PG8_BAR; PG8_WAIT_L(0); PG8_MMA(0, 0, At, B0); PG8_BAR; PG8_SCHED;
            PG8_LDB(B1, 1, 1); PG8_STAGE(PG8_SB(1, 0), b3, voffB);
            PG8_BAR; PG8_WAIT_L(0); PG8_MMA(0, 1, At, B1); PG8_BAR;
            PG8_LDA(At, 1, 1); PG8_STAGE(PG8_SA(1, 0), a3, voffA);
            PG8_BAR; PG8_WAIT_L(0); PG8_MMA(1, 0, At, B0); PG8_BAR; PG8_SCHED;
            PG8_STAGE(PG8_SB(1, 1), b3 + hstep, voffB);
            PG8_WAIT_V(6); PG8_BAR; PG8_MMA(1, 1, At, B1); PG8_BAR;
            }
        }
        if constexpr (ALIGN_EPI) { if (wr == 0) PG8_BAR; }
        if constexpr (!Epi::AFTER_DRAIN) { E(acc, cur, wr, wc, fr, fq, ui); S.done(cur); }
        if (!has_next) break;
#pragma unroll
        for (int a = 0; a < 2; ++a)
#pragma unroll
            for (int b = 0; b < 2; ++b)
#pragma unroll
                for (int m = 0; m < 4; ++m)
#pragma unroll
                    for (int n = 0; n < 2; ++n) acc[a][b][m][n] = (f32x4){0.f, 0.f, 0.f, 0.f};
        cur = nxt; cA = nA; cB = nB; ++ui;
        if constexpr (ALIGN_EPI) { if (wr == 1) PG8_BAR; }
    }
    PG8_WAIT_V(0);
    if constexpr (!ALIGN_EPI) { if (wr == 0) PG8_BAR; }
    PG8_BAR;
    if constexpr (Epi::AFTER_DRAIN) { E.fused(acc, cur, wr, wc, fr, fq, lds, wid, lane); S.done(cur); }
#undef PG8_SA
#undef PG8_SB
#undef PG8_STAGE
#undef PG8_LDA
#undef PG8_LDB
#undef PG8_MMA
#undef PG8_WAIT_V
#undef PG8_WAIT_L
#undef PG8_BAR
#undef PG8_SCHED
}
}

constexpr int KROW = 144, KIMG = 256 * KROW, VIMG = 256 * 128, KVIMG = KIMG + VIMG;
__device__ __forceinline__ void stage_kv(const bf16_t* base  , int ld, int kcol, int vcol, int j0, int dil, int rho,
                                         LAS unsigned char* Kl, LAS unsigned char* Vl, int t, int nthr) {
    for (int idx = t; idx < 2048; idx += nthr) { const int row = idx >> 3, ch = idx & 7, j = j0 + row;
        u32x4 kv = {0u, 0u, 0u, 0u}, vv = {0u, 0u, 0u, 0u};
        if (j >= 0) { const bf16_t* rp = base + (size_t)(j * dil + rho) * ld + ch * 8; kv = *(const u32x4*)(rp + kcol); vv = *(const u32x4*)(rp + vcol); }
        *(LAS u32x4*)(Kl + row * KROW + ch * 16) = kv;
        *(LAS u32x4*)(Vl + row * 128 + ((ch * 16) ^ (((row >> 1) & 1) << 6))) = vv; }
}
__device__ __forceinline__ void load_q(const bf16_t* qptr, size_t qstride, int lane, bf16x8 (&qf)[4]) {
#pragma unroll
    for (int ks = 0; ks < 4; ++ks) qf[ks] = *(const bf16x8*)(qptr + (size_t)(lane & 31) * qstride + 16 * ks + 8 * (lane >> 5));
}
template <int NIT> __device__ __forceinline__ void kv_fetch(const bf16_t* base, int ld, int kcol, int vcol, int j0, int dil, int rho, int t, int nthr, u32x4 (&kr)[NIT], u32x4 (&vr)[NIT]) {
#pragma unroll
    for (int i = 0; i < NIT; ++i) { const int idx = t + i * nthr, row = idx >> 3, ch = idx & 7, j = j0 + row; kr[i] = (u32x4){0u, 0u, 0u, 0u}; vr[i] = (u32x4){0u, 0u, 0u, 0u};
        if (j >= 0) { const bf16_t* rp = base + (size_t)(j * dil + rho) * ld + ch * 8; kr[i] = *(const u32x4*)(rp + kcol); vr[i] = *(const u32x4*)(rp + vcol); } }
}
template <int NIT> __device__ __forceinline__ void kv_commit(LAS unsigned char* Kl, LAS unsigned char* Vl, int t, int nthr, const u32x4 (&kr)[NIT], const u32x4 (&vr)[NIT]) {
#pragma unroll
    for (int i = 0; i < NIT; ++i) { const int idx = t + i * nthr, row = idx >> 3, ch = idx & 7;
        *(LAS u32x4*)(Kl + row * KROW + ch * 16) = kr[i]; *(LAS u32x4*)(Vl + row * 128 + ((ch * 16) ^ (((row >> 1) & 1) << 6))) = vr[i]; }
}
template <bool SINK, bool LSE_OUT, bool EDGE>
__device__ __forceinline__ void attn_qtile(LAS unsigned char* Kl, LAS unsigned char* Vl, int kv0, int i0, int jrow0, int max_dist,
                                           float sink2, bf16_t* optr, size_t ostride, float* lseptr, size_t lsestride, int lane, const bf16x8 (&qf)[4]) {
    const int l31 = lane & 31, hi = lane >> 5;
    f32x16 s[5];
    { LAS unsigned char* kp = Kl + (kv0 + l31) * KROW + 16 * hi;
#pragma unroll
      for (int tile = 0; tile < 5; ++tile) { f32x16 acc = {};
#pragma unroll
          for (int ks = 0; ks < 4; ++ks) { const bf16x8 kf = *(LAS bf16x8*)(kp + tile * 32 * KROW + ks * 32); acc = __builtin_amdgcn_mfma_f32_32x32x16_bf16(kf, qf[ks], acc, 0, 0, 0); }
          s[tile] = acc; } }
    const int i = i0 + l31; float mx = -INFINITY;
#pragma unroll
    for (int tile = 0; tile < 5; ++tile)
#pragma unroll
        for (int r = 0; r < 16; ++r) { const int j = jrow0 + kv0 + 32 * tile + crow(r, hi); const int dist = i - j;
            bool valid;
            if (EDGE) valid = (j >= 0) && (dist >= 0) && (dist <= max_dist);
            else valid = (tile == 0) ? (dist <= max_dist) : ((tile == 4) ? (dist >= 0) : true);
            const float x = valid ? s[tile][r] * QK_C2 : -INFINITY; s[tile][r] = x; mx = fmaxf(mx, x); }
    mx = fmaxf(mx, __shfl_xor(mx, 32));
    if (SINK) mx = fmaxf(mx, sink2);
    float lsum = 0.f;
#pragma unroll
    for (int tile = 0; tile < 5; ++tile)
#pragma unroll
        for (int r = 0; r < 16; ++r) { const float p = __builtin_amdgcn_exp2f(s[tile][r] - mx); s[tile][r] = p; lsum += p; }
    lsum += __shfl_xor(lsum, 32);
    if (SINK) lsum += __builtin_amdgcn_exp2f(sink2 - mx);
    f32x16 o0 = {}, o1 = {};
    { const int g = lane >> 4, qd = (lane & 15) >> 2, p_ = lane & 3, sw = (qd >> 1) & 1;
      LAS unsigned char* vrow = Vl + (kv0 + 4 * hi + qd) * 128 + (16 * (g & 1) + 4 * p_) * 2;
      LAS unsigned char* vb0 = vrow + 64 * sw; LAS unsigned char* vb1 = vrow + 64 * (sw ^ 1);
#pragma unroll
      for (int tile = 0; tile < 5; ++tile)
#pragma unroll
          for (int ss = 0; ss < 2; ++ss) {
              u32x4 pw; pw.x = pk2(s[tile][8 * ss + 0], s[tile][8 * ss + 1]); pw.y = pk2(s[tile][8 * ss + 2], s[tile][8 * ss + 3]); pw.z = pk2(s[tile][8 * ss + 4], s[tile][8 * ss + 5]); pw.w = pk2(s[tile][8 * ss + 6], s[tile][8 * ss + 7]);
              const bf16x8 pf = __builtin_bit_cast(bf16x8, pw);
              const int ro = (32 * tile + 16 * ss) * 128;
              const s16x4 a0 = __builtin_amdgcn_ds_read_tr16_b64_v4i16((LAS s16x4*)(vb0 + ro)), b0 = __builtin_amdgcn_ds_read_tr16_b64_v4i16((LAS s16x4*)(vb0 + ro + 8 * 128));
              const s16x4 a1 = __builtin_amdgcn_ds_read_tr16_b64_v4i16((LAS s16x4*)(vb1 + ro)), b1 = __builtin_amdgcn_ds_read_tr16_b64_v4i16((LAS s16x4*)(vb1 + ro + 8 * 128));
              const bf16x8 vf0 = {a0[0], a0[1], a0[2], a0[3], b0[0], b0[1], b0[2], b0[3]}, vf1 = {a1[0], a1[1], a1[2], a1[3], b1[0], b1[1], b1[2], b1[3]};
              o0 = __builtin_amdgcn_mfma_f32_32x32x16_bf16(vf0, pf, o0, 0, 0, 0);
              o1 = __builtin_amdgcn_mfma_f32_32x32x16_bf16(vf1, pf, o1, 0, 0, 0); } }
    const float inv = 1.0f / lsum;
    bf16_t* op = optr + (size_t)l31 * ostride + 4 * hi;
#pragma unroll
    for (int g4 = 0; g4 < 4; ++g4) { u32x2 w0, w1;
        w0.x = pk2(o0[4 * g4] * inv, o0[4 * g4 + 1] * inv); w0.y = pk2(o0[4 * g4 + 2] * inv, o0[4 * g4 + 3] * inv);
        w1.x = pk2(o1[4 * g4] * inv, o1[4 * g4 + 1] * inv); w1.y = pk2(o1[4 * g4 + 2] * inv, o1[4 * g4 + 3] * inv);
        *(u32x2*)(op + 8 * g4) = w0; *(u32x2*)(op + 32 + 8 * g4) = w1; }
    if (LSE_OUT) { if (hi == 0) lseptr[(size_t)l31 * lsestride] = mx + __builtin_amdgcn_logf(lsum); }
}
__device__ __forceinline__ void attnA_phase(const bf16_t* QKV, const float* sinks, bf16_t* MIX, LAS unsigned char* lds) {
    int tid = threadIdx.x; asm volatile("" : "+v"(tid));
    const int lane = tid & 63, wave = __builtin_amdgcn_readfirstlane(tid >> 6);
    LAS unsigned char* Kl = lds; LAS unsigned char* Vl = lds + KIMG;
    u32x4 kr[4], vr[4];
    { const int it = blockIdx.x; if (it < 512) { const int n = it & 63, kvh = (it >> 6) & 1, b = it >> 7; kv_fetch<4>(QKV + (size_t)b * SEQ * 768, 768, 512 + kvh * 64, 640 + kvh * 64, 128 * (n - 1), 1, 0, tid, NTHR, kr, vr); } }
    for (int it = blockIdx.x; it < 512; it += gridDim.x) { const int n = it & 63, kvh = (it >> 6) & 1, b = it >> 7;
        __syncthreads();
        kv_commit<4>(Kl, Vl, tid, NTHR, kr, vr);
        __syncthreads();
        const int ti0 = 2 * wave, head0 = kvh * 4 + (ti0 >> 2);
        bf16x8 qa[4], qb[4];
        { const size_t tokq = (size_t)b * SEQ + 128 * n + 32 * (ti0 & 3); load_q(QKV + tokq * 768 + head0 * 64, 768, lane, qa); load_q(QKV + (tokq + 32) * 768 + head0 * 64, 768, lane, qb); }
        { const int nx = it + gridDim.x; if (nx < 512) { const int n2 = nx & 63, kvh2 = (nx >> 6) & 1, b2 = nx >> 7; kv_fetch<4>(QKV + (size_t)b2 * SEQ * 768, 768, 512 + kvh2 * 64, 640 + kvh2 * 64, 128 * (n2 - 1), 1, 0, tid, NTHR, kr, vr); } }
        const float sk = sinks[head0] * LOG2E;
        { const int qt = ti0 & 3, i0 = 128 * n + 32 * qt; const size_t tok = (size_t)b * SEQ + i0;
          if (n == 0) attn_qtile<true, false, true>(Kl, Vl, 32 * qt, i0, 128 * (n - 1), 127, sk, MIX + tok * DM + head0 * 64, DM, nullptr, 0, lane, qa);
          else attn_qtile<true, false, false>(Kl, Vl, 32 * qt, i0, 128 * (n - 1), 127, sk, MIX + tok * DM + head0 * 64, DM, nullptr, 0, lane, qa); }
        { const int qt = (ti0 & 3) + 1, i0 = 128 * n + 32 * qt; const size_t tok = (size_t)b * SEQ + i0;
          if (n == 0) attn_qtile<true, false, true>(Kl, Vl, 32 * qt, i0, 128 * (n - 1), 127, sk, MIX + tok * DM + head0 * 64, DM, nullptr, 0, lane, qb);
          else attn_qtile<true, false, false>(Kl, Vl, 32 * qt, i0, 128 * (n - 1), 127, sk, MIX + tok * DM + head0 * 64, DM, nullptr, 0, lane, qb); }
    }
}
struct CItem { int br, b, head, dil, rho, n; };
__device__ __forceinline__ CItem citem(int it) { CItem c; c.br = it >> 11; const int rem = it & 2047; c.b = rem >> 9; c.head = (rem >> 6) & 7; const int w = rem & 63, lg = 2 * c.br; c.dil = 1 << lg; c.rho = w & (c.dil - 1); c.n = w >> lg; return c; }
__device__ __forceinline__ void attnC_phase(const bf16_t* PROJ, bf16_t* OB, float* LSE, LAS unsigned char* lds) {
    int tid = threadIdx.x; asm volatile("" : "+v"(tid));
    const int lane = tid & 63, wave = __builtin_amdgcn_readfirstlane(tid >> 6), hw = wave >> 2, qt = wave & 3;
    LAS unsigned char* Kl = lds + hw * KVIMG; LAS unsigned char* Vl = Kl + KIMG;
    u32x4 kr[8], vr[8];
    if ((int)blockIdx.x < 3072) { const CItem c = citem(2 * blockIdx.x + hw); kv_fetch<8>(PROJ + (size_t)c.b * SEQ * O_IN, O_IN, 512 + c.head * 64, 1024 + c.head * 64, 128 * (c.n - 1), c.dil, c.rho, tid & 255, 256, kr, vr); }
    for (int pr = blockIdx.x; pr < 3072; pr += gridDim.x) { const CItem c = citem(2 * pr + hw);
        __syncthreads();
        kv_commit<8>(Kl, Vl, tid & 255, 256, kr, vr);
        __syncthreads();
        const int i0 = 128 * c.n + 32 * qt; const size_t tok = (size_t)c.b * SEQ + (size_t)i0 * c.dil + c.rho;
        bf16x8 qf[4]; load_q(PROJ + tok * O_IN + c.head * 64, (size_t)c.dil * O_IN, lane, qf);
        { const int nx = pr + gridDim.x; if (nx < 3072) { const CItem c2 = citem(2 * nx + hw); kv_fetch<8>(PROJ + (size_t)c2.b * SEQ * O_IN, O_IN, 512 + c2.head * 64, 1024 + c2.head * 64, 128 * (c2.n - 1), c2.dil, c2.rho, tid & 255, 256, kr, vr); } }
        if (c.n == 0) attn_qtile<false, true, true>(Kl, Vl, 32 * qt, i0, 128 * (c.n - 1), 128, 0.f,
                                OB + (size_t)c.br * M * 512 + tok * 512 + c.head * 64, (size_t)c.dil * 512, LSE + (size_t)c.br * M * 8 + tok * 8 + c.head, (size_t)c.dil * 8, lane, qf);
        else attn_qtile<false, true, false>(Kl, Vl, 32 * qt, i0, 128 * (c.n - 1), 128, 0.f,
                                OB + (size_t)c.br * M * 512 + tok * 512 + c.head * 64, (size_t)c.dil * 512, LSE + (size_t)c.br * M * 8 + tok * 8 + c.head, (size_t)c.dil * 8, lane, qf);
    }
}
__device__ __forceinline__ void combine_phase(const bf16_t* OB, const float* LSE, bf16_t* MIX) {
    int tid_ = threadIdx.x; asm volatile("" : "+v"(tid_));
    const int gt = blockIdx.x * NTHR + tid_, NGT = gridDim.x * NTHR;
    for (int idx = gt; idx < M * 64; idx += NGT) { const int tok = idx >> 6, head = (idx >> 3) & 7, c = idx & 7;
        const float l0 = LSE[(size_t)tok * 8 + head], l1 = LSE[(size_t)M * 8 + (size_t)tok * 8 + head], l2 = LSE[(size_t)2 * M * 8 + (size_t)tok * 8 + head];
        const float mx = fmaxf(l0, fmaxf(l1, l2)); float a0 = __builtin_amdgcn_exp2f(l0 - mx), a1 = __builtin_amdgcn_exp2f(l1 - mx), a2 = __builtin_amdgcn_exp2f(l2 - mx);
        const float inv = 1.0f / (a0 + a1 + a2); a0 *= inv; a1 *= inv; a2 *= inv;
        const size_t off = (size_t)tok * 512 + head * 64 + c * 8;
        const u32x4 x0 = __builtin_nontemporal_load((const u32x4*)(OB + off)), x1 = __builtin_nontemporal_load((const u32x4*)(OB + (size_t)M * 512 + off)), x2 = __builtin_nontemporal_load((const u32x4*)(OB + (size_t)2 * M * 512 + off));
        u32x4 o;
        o.x = pk2(a0 * bflo(x0.x) + a1 * bflo(x1.x) + a2 * bflo(x2.x), a0 * bfhi(x0.x) + a1 * bfhi(x1.x) + a2 * bfhi(x2.x));
        o.y = pk2(a0 * bflo(x0.y) + a1 * bflo(x1.y) + a2 * bflo(x2.y), a0 * bfhi(x0.y) + a1 * bfhi(x1.y) + a2 * bfhi(x2.y));
        o.z = pk2(a0 * bflo(x0.z) + a1 * bflo(x1.z) + a2 * bflo(x2.z), a0 * bfhi(x0.z) + a1 * bfhi(x1.z) + a2 * bfhi(x2.z));
        o.w = pk2(a0 * bflo(x0.w) + a1 * bflo(x1.w) + a2 * bflo(x2.w), a0 * bfhi(x0.w) + a1 * bfhi(x1.w) + a2 * bfhi(x2.w));
        __builtin_nontemporal_store(o, (u32x4*)(MIX + (size_t)tok * DM + head * 64 + c * 8)); }
}

__device__ __forceinline__ void conv_phase_tiled(const bf16_t* CE, const float* cw, const float* cb, const float* lg, const float* lb, bf16_t* MIX, LAS unsigned char* lds) {
    int tid = threadIdx.x; asm volatile("" : "+v"(tid));
    const int lane = tid & 63, wave = tid >> 6, cp = tid & 255, th = tid >> 8;
    LAS unsigned char* xin = lds; LAS unsigned char* yb = lds + 62 * 1024;
    f32x2 w[31];
#pragma unroll
    for (int k = 0; k < 31; ++k) w[k] = *(const f32x2*)(cw + k * 512 + 2 * cp);
    const f32x2 bias = *(const f32x2*)(cb + 2 * cp);
    u32x4 pre[8];
#define CONV_FETCH(UN) do { const int tok0_ = (UN) * 32, t0_ = tok0_ & (SEQ - 1); _Pragma("unroll") for (int q = 0; q < 8; ++q) { const int idx = tid + q * NTHR, r = idx >> 6, c = idx & 63; pre[q] = (u32x4){0u, 0u, 0u, 0u}; \
        if (idx < 62 * 64 && t0_ - 30 + r >= 0) pre[q] = *(const u32x4*)(CE + (size_t)(tok0_ - 30 + r) * 512 + 8 * c); } } while (0)
    if ((int)blockIdx.x < M / 32) CONV_FETCH((int)blockIdx.x);
    for (int un = blockIdx.x; un < M / 32; un += gridDim.x) {
        const int tok0 = un * 32;
        __syncthreads();
#pragma unroll
        for (int q = 0; q < 8; ++q) { const int idx = tid + q * NTHR, r = idx >> 6, c = idx & 63; if (idx < 62 * 64) *(LAS u32x4*)(xin + r * 1024 + 16 * c) = pre[q]; }
        __syncthreads();
        if (un + (int)gridDim.x < M / 32) CONV_FETCH(un + (int)gridDim.x);
        f32x2 acc[16];
#pragma unroll
        for (int i = 0; i < 16; ++i) acc[i] = bias;
#pragma unroll
        for (int r = 0; r < 46; ++r) { const unsigned xv = *(LAS unsigned*)(xin + (th * 16 + r) * 1024 + 4 * cp); const f32x2 x = {bflo(xv), bfhi(xv)};
#pragma unroll
            for (int tt = 0; tt < 16; ++tt) if (r - tt >= 0 && r - tt <= 30) acc[tt] += w[r - tt] * x; }
#pragma unroll
        for (int i = 0; i < 16; ++i) *(LAS f32x2*)(yb + (th * 16 + i) * 2048 + 8 * cp) = acc[i];
        __syncthreads();
#pragma unroll
        for (int i = 0; i < 4; ++i) { const int tt = wave * 4 + i;
            const f32x4 y0 = *(LAS f32x4*)(yb + tt * 2048 + 32 * lane), y1 = *(LAS f32x4*)(yb + tt * 2048 + 32 * lane + 16);
            float a[8] = {y0.x, y0.y, y0.z, y0.w, y1.x, y1.y, y1.z, y1.w}; float s = 0.f;
#pragma unroll
            for (int j = 0; j < 8; ++j) s += a[j];
            const float mean = wave_sum(s) * (1.f / 512.f); float q = 0.f;
#pragma unroll
            for (int j = 0; j < 8; ++j) { a[j] -= mean; q += a[j] * a[j]; }
            const float rstd = 1.0f / sqrtf(wave_sum(q) * (1.f / 512.f) + 1e-5f);
            const f32x4 g0 = *(const f32x4*)(lg + 8 * lane), g1 = *(const f32x4*)(lg + 8 * lane + 4), e0 = *(const f32x4*)(lb + 8 * lane), e1 = *(const f32x4*)(lb + 8 * lane + 4);
            u32x4 o; o.x = pk2(siluf_(a[0] * rstd * g0.x + e0.x), siluf_(a[1] * rstd * g0.y + e0.y)); o.y = pk2(siluf_(a[2] * rstd * g0.z + e0.z), siluf_(a[3] * rstd * g0.w + e0.w));
            o.z = pk2(siluf_(a[4] * rstd * g1.x + e1.x), siluf_(a[5] * rstd * g1.y + e1.y)); o.w = pk2(siluf_(a[6] * rstd * g1.z + e1.z), siluf_(a[7] * rstd * g1.w + e1.w));
            __builtin_nontemporal_store(o, (u32x4*)(MIX + (size_t)(tok0 + tt) * DM + 512 + 8 * lane)); }
    }
}

#undef CONV_FETCH
__device__ __forceinline__ void gmlp_phase(const bf16_t* PROJ, const float* lg, const float* lb, const bf16_t* SPW, const float* sb, bf16_t* MIX, LAS unsigned char* lds) {
    int tid = threadIdx.x; asm volatile("" : "+v"(tid));
    const int lane = tid & 63, wave = tid >> 6, l31 = lane & 31, hi = lane >> 5;
    for (int un = blockIdx.x; un < 512; un += gridDim.x) { const int ch = un >> 1, gh = un & 1;
        __syncthreads();
        u32x4 gin[16];
#pragma unroll
        for (int i = 0; i < 16; ++i) gin[i] = *(const u32x4*)(PROJ + ((size_t)ch * 128 + wave * 16 + i) * O_IN + 2048 + 8 * lane);
#pragma unroll
        for (int i = 0; i < 16; ++i) { const int tk = wave * 16 + i;
            const u32x4 w = gin[i];
            float a[8] = {bflo(w.x), bfhi(w.x), bflo(w.y), bfhi(w.y), bflo(w.z), bfhi(w.z), bflo(w.w), bfhi(w.w)}; float s = 0.f;
#pragma unroll
            for (int j = 0; j < 8; ++j) s += a[j];
            const float mean = wave_sum(s) * (1.f / 512.f); float q = 0.f;
#pragma unroll
            for (int j = 0; j < 8; ++j) { a[j] -= mean; q += a[j] * a[j]; }
            const float rstd = 1.0f / sqrtf(wave_sum(q) * (1.f / 512.f) + 1e-5f);
            if ((lane >> 5) == gh) { const f32x4 g0 = *(const f32x4*)(lg + 8 * lane), g1 = *(const f32x4*)(lg + 8 * lane + 4), e0 = *(const f32x4*)(lb + 8 * lane), e1 = *(const f32x4*)(lb + 8 * lane + 4);
                u32x4 o; o.x = pk2(a[0] * rstd * g0.x + e0.x, a[1] * rstd * g0.y + e0.y); o.y = pk2(a[2] * rstd * g0.z + e0.z, a[3] * rstd * g0.w + e0.w);
                o.z = pk2(a[4] * rstd * g1.x + e1.x, a[5] * rstd * g1.y + e1.y); o.w = pk2(a[6] * rstd * g1.z + e1.z, a[7] * rstd * g1.w + e1.w);
                *(LAS u32x4*)(lds + tk * 512 + ((16 * l31) ^ ((tk & 3) << 6))) = o; } }
        __syncthreads();
        const int gl = wave >> 1, ddt = wave & 1, grp = 4 * gh + gl;
        const int g = lane >> 4, qd = (lane & 15) >> 2, p_ = lane & 3;
        LAS unsigned char* bp = lds + (8 * hi + qd) * 512 + ((128 * gl + 64 * ddt + 32 * (g & 1) + 8 * p_) ^ (qd << 6));
        bf16x8 bfr[8];
#pragma unroll
        for (int ks = 0; ks < 8; ++ks) { const s16x4 x0 = __builtin_amdgcn_ds_read_tr16_b64_v4i16((LAS s16x4*)(bp + (16 * ks) * 512)), x1 = __builtin_amdgcn_ds_read_tr16_b64_v4i16((LAS s16x4*)(bp + (16 * ks + 4) * 512));
            bfr[ks] = (bf16x8){x0[0], x0[1], x0[2], x0[3], x1[0], x1[1], x1[2], x1[3]}; }
        const bf16_t* wbase = SPW + (size_t)grp * 128 * 128 + 8 * hi;
        const int chn = 64 * grp + 32 * ddt + l31;
#pragma unroll
        for (int tt = 0; tt < 4; ++tt) { f32x16 acc = {};
            const bf16_t* wp = wbase + (size_t)(32 * tt + l31) * 128;
#pragma unroll
            for (int ks = 0; ks < 8; ++ks) if (ks < 2 * tt + 2) { const bf16x8 af = *(const bf16x8*)(wp + 16 * ks); acc = __builtin_amdgcn_mfma_f32_32x32x16_bf16(af, bfr[ks], acc, 0, 0, 0); }
#pragma unroll
            for (int r = 0; r < 16; ++r) { const int t = 32 * tt + crow(r, hi); const size_t row = (size_t)ch * 128 + t;
                const float u = bf2f(PROJ[row * O_IN + 1536 + chn]); MIX[row * DM + 512 + chn] = (bf16_t)f2bf(u * (acc[r] + sb[grp * 128 + t])); } }
    }
}

__device__ __forceinline__ void final_norm(const bf16_t* HB, const float* ss, const float* g, float* out) {
    int tid_ = threadIdx.x; asm volatile("" : "+v"(tid_));
    const int lane = tid_ & 63, wave = tid_ >> 6; const int gw = blockIdx.x * NWAVE + wave, NGW = gridDim.x * NWAVE;
    const f32x4 g0 = *(const f32x4*)(g + 8 * lane), g1 = *(const f32x4*)(g + 8 * lane + 4), g2 = *(const f32x4*)(g + 512 + 8 * lane), g3 = *(const f32x4*)(g + 512 + 8 * lane + 4);
    for (int m = gw; m < M; m += NGW) { const float rs = row_rstd(ss, m);
        const u32x4 w0 = __builtin_nontemporal_load((const u32x4*)(HB + (size_t)m * DM + 8 * lane)), w1 = __builtin_nontemporal_load((const u32x4*)(HB + (size_t)m * DM + 512 + 8 * lane));
        float* o = out + (size_t)m * DM + 8 * lane;
        __builtin_nontemporal_store((f32x4){bflo(w0.x), bfhi(w0.x), bflo(w0.y), bfhi(w0.y)} * rs * g0, (f32x4*)(o)); __builtin_nontemporal_store((f32x4){bflo(w0.z), bfhi(w0.z), bflo(w0.w), bfhi(w0.w)} * rs * g1, (f32x4*)(o + 4));
        __builtin_nontemporal_store((f32x4){bflo(w1.x), bfhi(w1.x), bflo(w1.y), bfhi(w1.y)} * rs * g2, (f32x4*)(o + 512)); __builtin_nontemporal_store((f32x4){bflo(w1.z), bfhi(w1.z), bflo(w1.w), bfhi(w1.w)} * rs * g3, (f32x4*)(o + 516)); }
}

typedef __attribute__((address_space(1))) unsigned gu32;
#define XB_TMO      128
#define XB_XCNT(j)  (256  + 64 * (j))
#define XB_XSUB(j)  (1280 + 64 * (j))
#define XB_XGEN(j)  (2304 + 64 * (j))
#define XB_TOP      3328
#define XB_TOPGEN   3392
#define XCD_BAR_WORDS 3456
#define XB_SPIN_CAP (1u << 18)

__device__ __forceinline__ unsigned xb_ld(unsigned* p)              { return __hip_atomic_load(p, __ATOMIC_RELAXED, __HIP_MEMORY_SCOPE_AGENT); }
__device__ __forceinline__ unsigned xb_add(unsigned* p, unsigned v) { return __hip_atomic_fetch_add(p, v, __ATOMIC_RELAXED, __HIP_MEMORY_SCOPE_AGENT); }
__device__ __forceinline__ unsigned xb_xcc_id() { return (unsigned)__builtin_amdgcn_s_getreg((3 << 11) | 20) & 0xFu; }
#define XB_SPIN(cond, bar) do { unsigned _sp = 0; while (cond) { __builtin_amdgcn_s_sleep(1); \
    if ((++_sp & 255u) == 0u) { if (xb_ld(&(bar)[XB_TMO])) break; if (_sp > XB_SPIN_CAP) { atomicAdd(&(bar)[XB_TMO], 1u); break; } } } } while (0)

struct XcdBarrier {
    unsigned* bar; unsigned x;
    volatile LAS unsigned* st;
};

__device__ __forceinline__ XcdBarrier xcd_barrier_post(unsigned* bar, volatile LAS unsigned* st) {
    XcdBarrier b; b.bar = bar; b.x = xb_xcc_id(); b.st = st;
    if (threadIdx.x == 0) (void)xb_add(&bar[XB_XCNT(b.x)], 1u);
    return b;
}
__device__ __forceinline__ void xcd_barrier_complete(unsigned* bar, unsigned x, unsigned& nloc, unsigned& nx) {
    const unsigned G = gridDim.x * gridDim.y * gridDim.z;
    unsigned sum, cnt, mine, sp = 0u;
    for (;;) {
        sum = 0u; cnt = 0u; mine = 0u;
#pragma unroll
        for (unsigned j = 0; j < 16; ++j) { const unsigned c = xb_ld(&bar[XB_XCNT(j)]); sum += c; cnt += (c > 0u) ? 1u : 0u; mine = (j == x) ? c : mine; }
        if (sum == G) break;
        __builtin_amdgcn_s_sleep(1);
        if ((++sp & 255u) == 0u) { if (xb_ld(&bar[XB_TMO])) break; if (sp > XB_SPIN_CAP) { atomicAdd(&bar[XB_TMO], 1u); break; } }
    }
    nloc = mine > 0u ? mine : 1u; nx = cnt > 0u ? cnt : 1u;
}

__device__ __forceinline__ void xcd_barrier(const XcdBarrier& b) {
    asm volatile("s_waitcnt vmcnt(0)" ::: "memory");
    __syncthreads();
    if (threadIdx.x == 0) {
        unsigned* bar = b.bar;
        __builtin_amdgcn_s_waitcnt(0);
        unsigned nloc = b.st[0], nx = b.st[1];
        if (nloc == 0u) { xcd_barrier_complete(bar, b.x, nloc, nx); b.st[0] = nloc; b.st[1] = nx; }
        const unsigned old = xb_add(&bar[XB_XSUB(b.x)], 1u);
        const unsigned gen = old / nloc;
        if (old + 1u == (gen + 1u) * nloc) {
            __builtin_amdgcn_fence(__ATOMIC_RELEASE, "agent");
            asm volatile("s_waitcnt vmcnt(0)" ::: "memory");
            const unsigned og = xb_add(&bar[XB_TOP], 1u);
            const unsigned tg = og / nx;
            if (og + 1u == (tg + 1u) * nx) xb_add(&bar[XB_TOPGEN], 1u);
            else XB_SPIN(xb_ld(&bar[XB_TOPGEN]) == tg, bar);
            __builtin_amdgcn_fence(__ATOMIC_ACQUIRE, "agent");
            xb_add(&bar[XB_XGEN(b.x)], 1u);
            asm volatile("s_waitcnt vmcnt(0)" ::: "memory");
        } else {
            XB_SPIN(xb_ld(&bar[XB_XGEN(b.x)]) == gen, bar);
            __builtin_amdgcn_fence(__ATOMIC_ACQUIRE, "agent");
            asm volatile("s_waitcnt vmcnt(0)" ::: "memory");
        }
    }
    __syncthreads();
}

template <int L> __device__ __forceinline__ void layer_body(const Params& P, LAS unsigned char* lds, const XcdBarrier& xbar) {
    unsigned char* ws = P.ws;
    const float* cosT = (const float*)(ws + WS_COS); const float* sinT = (const float*)(ws + WS_SIN);
    float* SS = (float*)(ws + WS_SS); bf16_t* HB = (bf16_t*)(ws + WS_HB); bf16_t* MIX = (bf16_t*)(ws + WS_MIX);
    bf16_t* R1 = (bf16_t*)(ws + WS_R1); bf16_t* CE = (bf16_t*)(ws + WS_CE); float* H = P.out;
        if (L == 0) { pg8::Gemm g{HB, (const bf16_t*)(ws + WS_W_EIN), M, E_IN, DM}; pg8::StaticOrder S; S.init(M, E_IN, (int)gridDim.x, (int)blockIdx.x);
            pg8::rs_precompute(SS, S, lds); pg8::EpiIn<0> E{(LAS const float*)(lds + pg8::RSL_OFF), cosT, sinT, R1, CE}; pg8::gemm_phase<pg8::EpiIn<0>, pg8::StaticOrder, true, true>(lds, g, S, E);
            { const int G = (int)gridDim.x, nwg = (M / 256) * (E_IN / 256), rounds = (nwg + G - 1) / G, thr = nwg - (rounds - 1) * G, nidle = G - thr;
              const int wv = threadIdx.x >> 6;
              if (nidle <= 0) convert_weights(P, lds, CONV_SPLIT, NITEMS, (int)blockIdx.x * NWAVE + wv, G * NWAVE);
              else if ((int)blockIdx.x >= thr) convert_weights(P, lds, CONV_SPLIT, NITEMS, ((int)blockIdx.x - thr) * NWAVE + wv, nidle * NWAVE); } }
        else { pg8::Gemm g{HB, (const bf16_t*)(ws + WS_W_OIN), M, O_IN, DM}; pg8::StaticOrder S; S.init(M, O_IN, (int)gridDim.x, (int)blockIdx.x);
            pg8::rs_precompute(SS, S, lds); pg8::EpiIn<1> E{(LAS const float*)(lds + pg8::RSL_OFF), cosT, sinT, R1, nullptr}; pg8::gemm_phase<pg8::EpiIn<1>, pg8::StaticOrder, true, true>(lds, g, S, E); }
        xcd_barrier(xbar);
        if (L == 0) { attnA_phase(R1, P.in[3], MIX, lds); __syncthreads(); conv_phase_tiled(CE, P.in[4], P.in[5], P.in[6], P.in[7], MIX, lds); }
        else { attnC_phase(R1, (bf16_t*)(ws + WS_OB), (float*)(ws + WS_LSE), lds); __syncthreads(); gmlp_phase(R1, P.in[11], P.in[12], (const bf16_t*)(ws + WS_SPW), P.in[14], MIX, lds);
            xcd_barrier(xbar); combine_phase((const bf16_t*)(ws + WS_OB), (const float*)(ws + WS_LSE), MIX); }
        xcd_barrier(xbar);
        { pg8::Gemm g{MIX, (const bf16_t*)(ws + (L ? WS_W_OOUT : WS_W_EOUT)), M, DM, DM}; pg8::StaticOrder S; S.init(M, DM, (int)gridDim.x, (int)blockIdx.x);
          pg8::EpiRes<false> E{nullptr, HB, SS}; pg8::gemm_phase<pg8::EpiRes<false>, pg8::StaticOrder, true, true>(lds, g, S, E); }
        xcd_barrier(xbar);
        { pg8::Gemm g{HB, (const bf16_t*)(ws + (L ? WS_W_GU1 : WS_W_GU0)), M, 2 * DFF, DM}; pg8::StaticOrder S; S.init(M, 2 * DFF, (int)gridDim.x, (int)blockIdx.x);
          pg8::rs_precompute(SS, S, lds); pg8::EpiGU E{(LAS const float*)(lds + pg8::RSL_OFF), R1}; pg8::gemm_phase<pg8::EpiGU, pg8::StaticOrder, true, true>(lds, g, S, E); }
        xcd_barrier(xbar);
        { pg8::Gemm g{R1, (const bf16_t*)(ws + (L ? WS_W_DN1 : WS_W_DN0)), M, DM, DFF}; pg8::StaticOrder S; S.init(M, DM, (int)gridDim.x, (int)blockIdx.x);
          pg8::EpiRes<false> E{nullptr, HB, SS}; pg8::gemm_phase<pg8::EpiRes<false>, pg8::StaticOrder, true, true>(lds, g, S, E); }
        xcd_barrier(xbar);
}

__global__ void __launch_bounds__(NTHR, 2) fwd_kernel(Params P) {
    extern __shared__ __attribute__((aligned(16))) unsigned char lds_raw[];
    LAS unsigned char* lds = (LAS unsigned char*)lds_raw;
    cg::grid_group grid = cg::this_grid();
    unsigned char* ws = P.ws;
    const float* cosT = (const float*)(ws + WS_COS); const float* sinT = (const float*)(ws + WS_SIN);
    float* SS = (float*)(ws + WS_SS); bf16_t* HB = (bf16_t*)(ws + WS_HB); bf16_t* MIX = (bf16_t*)(ws + WS_MIX);
    bf16_t* R1 = (bf16_t*)(ws + WS_R1); bf16_t* CE = (bf16_t*)(ws + WS_CE); float* H = P.out;

    volatile LAS unsigned* xst = (volatile LAS unsigned*)(lds + LDS_BYTES - 64);
    if (threadIdx.x < 2) xst[threadIdx.x] = 0u;
    __syncthreads();
    const XcdBarrier xbar = xcd_barrier_post((unsigned*)(ws + WS_BAR), xst);
    p0_prologue(P, lds);
    xcd_barrier(xbar);
    if (gridDim.x == 0x7fffffffu) grid.sync();
    layer_body<0>(P, lds, xbar);
    layer_body<1>(P, lds, xbar);
    final_norm(HB, SS, P.in[20], P.out);
}

extern "C" void kernel_launch(void* const* d_in, const int* in_sizes, int n_in, void* d_out, int out_size, void* d_ws, size_t ws_size, hipStream_t stream) {
    static int grid = 0;
    if (grid == 0) {
        if (n_in != 21 || out_size != M * DM || ws_size < WS_END) { fprintf(stderr, "kernel_launch: unexpected problem (n_in %d, out %d, ws %zu)\n", n_in, out_size, ws_size); grid = -1; return; }
        int dev = 0, cus = 0, per_cu = 0;
        hipGetDevice(&dev); hipDeviceGetAttribute(&cus, hipDeviceAttributeMultiprocessorCount, dev);
        hipFuncSetAttribute((const void*)fwd_kernel, hipFuncAttributeMaxDynamicSharedMemorySize, LDS_BYTES);
        hipOccupancyMaxActiveBlocksPerMultiprocessor(&per_cu, (const void*)fwd_kernel, NTHR, LDS_BYTES);
        if (per_cu < 1) { fprintf(stderr, "kernel_launch: occupancy query says %d blocks/CU\n", per_cu); per_cu = 1; }
        grid = cus * per_cu;
        fprintf(stderr, "kernel_launch: grid %d (cus %d x %d)\n", grid, cus, per_cu);
    }
    if (grid < 0) return;
    Params p{};
    for (int i = 0; i < 21; ++i) p.in[i] = (const float*)d_in[i];
    p.out = (float*)d_out; p.ws = (unsigned char*)d_ws;
    if (hipMemsetAsync((unsigned char*)d_ws + WS_BAR, 0, BAR_BYTES, stream) != hipSuccess) { fprintf(stderr, "kernel_launch: memset failed\n"); return; }
    void* args[] = {&p};
    hipError_t e = hipLaunchCooperativeKernel((const void*)fwd_kernel, dim3(grid), dim3(NTHR), args, LDS_BYTES, stream);
    if (e != hipSuccess) fprintf(stderr, "cooperative launch failed: %s (grid %d)\n", hipGetErrorString(e), grid);
}
```

```cpp
#include <hip/hip_runtime.h>
#include <hip/hip_cooperative_groups.h>
#include <cstdio>
#include <cstdint>
namespace cg = cooperative_groups;

#define LAS __attribute__((address_space(3)))
typedef unsigned short bf16_t;
typedef short bf16x8 __attribute__((ext_vector_type(8)));
typedef short s16x4 __attribute__((ext_vector_type(4)));
typedef float f32x4 __attribute__((ext_vector_type(4)));
typedef float f32x2 __attribute__((ext_vector_type(2)));
typedef float f32x16 __attribute__((ext_vector_type(16)));
typedef unsigned u32x4 __attribute__((ext_vector_type(4)));
typedef unsigned u32x2 __attribute__((ext_vector_type(2)));

constexpr int M = 32768, DM = 1024, SEQ = 8192, DFF = 2816, E_IN = 1792, O_IN = 2560;
constexpr int NTHR = 512, NWAVE = 8;
constexpr float LOG2E = 1.4426950408889634f;
constexpr float QK_C2 = 0.125f * LOG2E;

constexpr size_t KiB = 1024, MiB = 1024 * 1024;
constexpr size_t WS_BAR = 512 * KiB, BAR_BYTES = 16 * KiB;
constexpr size_t WS_COS = 0, WS_SIN = 256 * KiB, WS_SPW = 1 * MiB, WS_SS = 2 * MiB;
constexpr size_t WS_W_EIN = 4 * MiB, WS_W_EOUT = WS_W_EIN + 3584 * KiB, WS_W_GU0 = WS_W_EOUT + 2 * MiB, WS_W_GU1 = WS_W_GU0 + 11 * MiB;
constexpr size_t WS_W_DN0 = WS_W_GU1 + 11 * MiB, WS_W_DN1 = WS_W_DN0 + 5632 * KiB, WS_W_OIN = WS_W_DN1 + 5632 * KiB, WS_W_OOUT = WS_W_OIN + 5 * MiB;
constexpr size_t WS_R1 = 50 * MiB;
constexpr size_t WS_CE = WS_R1 + 48 * MiB;
constexpr size_t WS_MIX = 226 * MiB, WS_HB = 290 * MiB, WS_OB = 354 * MiB, WS_LSE = 450 * MiB, WS_END = 453 * MiB;
static_assert(WS_W_OOUT + 2 * MiB <= WS_R1, "weights fit");

constexpr int LDS_BYTES = 147456;

struct Params { const float* in[21]; float* out; unsigned char* ws; };

__device__ __forceinline__ unsigned f2bf(float f) { unsigned u = __builtin_bit_cast(unsigned, f); return (u + 0x7fffu + ((u >> 16) & 1u)) >> 16; }
typedef __bf16 bf16x2_t __attribute__((ext_vector_type(2)));
__device__ __forceinline__ unsigned pk2(float lo, float hi) { const f32x2 v = {lo, hi}; const bf16x2_t b = __builtin_convertvector(v, bf16x2_t); return __builtin_bit_cast(unsigned, b); }
__device__ __forceinline__ float bf2f(unsigned short b) { return __builtin_bit_cast(float, (unsigned)b << 16); }
__device__ __forceinline__ float bflo(unsigned w) { return __builtin_bit_cast(float, w << 16); }
__device__ __forceinline__ float bfhi(unsigned w) { return __builtin_bit_cast(float, w & 0xffff0000u); }
__device__ __forceinline__ int crow(int r, int hi) { return (r & 3) + 8 * (r >> 2) + 4 * hi; }
__device__ __forceinline__ float wave_sum(float v) {
#pragma unroll
    for (int o = 1; o < 64; o <<= 1) v += __shfl_xor(v, o);
    return v;
}
__device__ __forceinline__ float sigmoidf_(float x) { return __builtin_amdgcn_rcpf(1.f + __builtin_amdgcn_exp2f(-x * LOG2E)); }
__device__ __forceinline__ float siluf_(float x) { return x * sigmoidf_(x); }
__device__ __forceinline__ float gelu_tanh(float x) {
    const float y = 0.7978845608028654f * (x + 0.044715f * x * x * x);
    const float t = __builtin_amdgcn_exp2f(2.f * LOG2E * y);
    const float th = 1.f - 2.f * __builtin_amdgcn_rcpf(t + 1.f);
    return 0.5f * x * (1.f + th);
}
__device__ __forceinline__ float row_rstd(const float* ss, int row) {
    const f32x4* p = (const f32x4*)(ss + (size_t)row * 16);
    f32x4 a = p[0], b = p[1], c = p[2], d = p[3];
    const float s = ((a.x + a.y) + (a.z + a.w)) + ((b.x + b.y) + (b.z + b.w)) + ((c.x + c.y) + (c.z + c.w)) + ((d.x + d.y) + (d.z + d.w));
    return 1.0f / sqrtf(s * (1.0f / 1024.0f) + 1e-6f);
}

__device__ __forceinline__ void p0_transpose_item(const float* W, int ldn, int K, int k0, int srccol, const float* g, bf16_t* WT, int dstrow, LAS float* scr, int lane) {
    { f32x4 v[8]; const int c4 = (lane & 7) * 4;
#pragma unroll
      for (int i = 0; i < 8; ++i) v[i] = __builtin_nontemporal_load((const f32x4*)(W + (size_t)(k0 + 8 * i + (lane >> 3)) * ldn + srccol + c4));
#pragma unroll
      for (int i = 0; i < 8; ++i) { const int kk = 8 * i + (lane >> 3); const float gs = g ? g[k0 + kk] : 1.f; LAS float* d = scr + kk * 33 + c4; d[0] = v[i].x * gs; d[1] = v[i].y * gs; d[2] = v[i].z * gs; d[3] = v[i].w * gs; } }
    asm volatile("s_waitcnt lgkmcnt(0)" ::: "memory");
    const int c = lane & 7;
#pragma unroll
    for (int j = 0; j < 4; ++j) { const int n = (lane >> 3) + 8 * j; const LAS float* s = scr + (8 * c) * 33 + n;
        u32x4 o; o.x = pk2(s[0 * 33], s[1 * 33]); o.y = pk2(s[2 * 33], s[3 * 33]); o.z = pk2(s[4 * 33], s[5 * 33]); o.w = pk2(s[6 * 33], s[7 * 33]);
        __builtin_nontemporal_store(o, (u32x4*)(WT + (size_t)(dstrow + n) * K + k0 + 8 * c)); }
    asm volatile("s_waitcnt lgkmcnt(0)" ::: "memory");
}
constexpr int I_EIN = 16 * 56, I_EOUT = 16 * 32, I_GU = 16 * 176, I_DN = 44 * 32, I_OIN = 16 * 80, I_OOUT = 16 * 32;
constexpr int NITEMS = I_EIN + I_EOUT + 2 * I_GU + 2 * I_DN + I_OIN + I_OOUT;
constexpr int CONV_SPLIT = 7500;
__device__ __forceinline__ void convert_weights(const Params& P, LAS unsigned char* lds, int it0, int it1, int wk, int nwk) {
    int tid = threadIdx.x; asm volatile("" : "+v"(tid));
    const int lane = tid & 63, wave = tid >> 6;
    LAS float* scr = (LAS float*)(lds + wave * 16384);
    unsigned char* ws = P.ws;
    for (int it = it0 + wk; it < it1; it += nwk) {
        int r = it;
        if (r < I_EIN) { const int nb = r % 56, kb = r / 56; int src;
            if (nb < 24) src = 32 * nb; else { const int q = nb - 24, p = q >> 3, w = q & 7; src = 768 + (w >> 2) * 512 + 128 * p + (w & 3) * 32; }
            p0_transpose_item(P.in[2], E_IN, DM, 64 * kb, src, P.in[1], (bf16_t*)(ws + WS_W_EIN), 32 * nb, scr, lane); continue; }
        r -= I_EIN;
        if (r < I_EOUT) { const int nb = r % 32, kb = r / 32; p0_transpose_item(P.in[8], DM, DM, 64 * kb, 32 * nb, nullptr, (bf16_t*)(ws + WS_W_EOUT), 32 * nb, scr, lane); continue; }
        r -= I_EOUT;
        if (r < 2 * I_GU) { const int L = r / I_GU; r -= L * I_GU; const int nb = r % 176, kb = r / 176, p = nb >> 3, w = nb & 7;
            const float* src = ((w >> 2) ? P.in[18] : P.in[17]) + (size_t)L * DM * DFF;
            p0_transpose_item(src, DFF, DM, 64 * kb, 128 * p + (w & 3) * 32, P.in[16] + L * DM, (bf16_t*)(ws + (L ? WS_W_GU1 : WS_W_GU0)), 32 * nb, scr, lane); continue; }
        r -= 2 * I_GU;
        if (r < 2 * I_DN) { const int L = r / I_DN; r -= L * I_DN; const int nb = r % 32, kb = r / 32;
            p0_transpose_item(P.in[19] + (size_t)L * DFF * DM, DM, DFF, 64 * kb, 32 * nb, nullptr, (bf16_t*)(ws + (L ? WS_W_DN1 : WS_W_DN0)), 32 * nb, scr, lane); continue; }
        r -= 2 * I_DN;
        if (r < I_OIN) { const int nb = r % 80, kb = r / 80; p0_transpose_item(P.in[10], O_IN, DM, 64 * kb, 32 * nb, P.in[9], (bf16_t*)(ws + WS_W_OIN), 32 * nb, scr, lane); continue; }
        r -= I_OIN;
        { const int nb = r % 32, kb = r / 32; p0_transpose_item(P.in[15], DM, DM, 64 * kb, 32 * nb, nullptr, (bf16_t*)(ws + WS_W_OOUT), 32 * nb, scr, lane); }
    }
}
__device__ __forceinline__ void p0_prologue(const Params& P, LAS unsigned char* lds) {
    int tid = threadIdx.x; asm volatile("" : "+v"(tid));
    const int lane = tid & 63, wave = tid >> 6;
    const int gw = blockIdx.x * NWAVE + wave, NGW = gridDim.x * NWAVE;
    unsigned char* ws = P.ws;
    convert_weights(P, lds, 0, CONV_SPLIT, gw, NGW);
    const int gt = blockIdx.x * NTHR + tid, NGT = gridDim.x * NTHR;
    for (int i = gt; i < SEQ * 8; i += NGT) { const int pos = i >> 3, f = i & 7;
        const float inv = (float)pow(500000.0, -(double)f * 0.125); const float ang = (float)pos * inv;
        ((float*)(ws + WS_COS))[i] = (float)cos((double)ang); ((float*)(ws + WS_SIN))[i] = (float)sin((double)ang); }
    for (int i = gt; i < 8 * 128 * 128; i += NGT) { const int s = i & 127, t = (i >> 7) & 127; ((bf16_t*)(ws + WS_SPW))[i] = (s <= t) ? (bf16_t)f2bf(P.in[13][i]) : (bf16_t)0; }
    const float* x = P.in[0]; bf16_t* HB = (bf16_t*)(ws + WS_HB); float* SS = (float*)(ws + WS_SS);
    for (int m0 = gw * 4; m0 < M; m0 += NGW * 4) {
        f32x4 v[4][4];
#pragma unroll
        for (int r = 0; r < 4; ++r)
#pragma unroll
            for (int j = 0; j < 4; ++j) v[r][j] = __builtin_nontemporal_load((const f32x4*)(x + (size_t)(m0 + r) * DM) + lane + 64 * j);
#pragma unroll
        for (int r = 0; r < 4; ++r) { float s = 0.f; unsigned long long* o8 = (unsigned long long*)(HB + (size_t)(m0 + r) * DM) + lane;
#pragma unroll
            for (int j = 0; j < 4; ++j) { const f32x4 t = v[r][j]; s += (t.x * t.x + t.y * t.y) + (t.z * t.z + t.w * t.w);
                __builtin_nontemporal_store((unsigned long long)pk2(t.x, t.y) | ((unsigned long long)pk2(t.z, t.w) << 32), o8 + 64 * j); }
            s = wave_sum(s);
            if (lane < 16) SS[(size_t)(m0 + r) * 16 + lane] = (lane == 0) ? s : 0.f; }
    }
}

namespace pg8 {
#define PG8_LAS __attribute__((address_space(3)))
constexpr int BM = 256, BK = 64, HALF = 128, HTB = HALF * BK * 2  , STAGE_BYTES = 8 * HTB, NXCD = 8, WGM = 8;

__host__ __device__ __forceinline__ int lds_byte(int r, int c) { const int st = (r >> 4) * 2 + (c >> 5), rr = r & 15, cc = c & 31, ob = rr * 64 + cc * 2; return st * 1024 + (ob ^ (((ob >> 9) & 1) << 5)); }
__host__ __device__ __forceinline__ void stage_rc(int b, int& R, int& C) { const int st = b / 1024, sb = b % 1024, swz = sb ^ (((sb >> 9) & 1) << 5); R = (st >> 1) * 16 + swz / 64; C = (st & 1) * 32 + (swz % 64) / 2; }
__host__ __device__ __forceinline__ int perm32(int rho) { const int n = rho >> 4, i = rho & 15; return 8 * (i >> 2) + 4 * n + (i & 3); }

struct Unit { int pm, pn; };
struct Gemm { const bf16_t* A; const bf16_t* Bt; int M, N, K; };

struct StaticOrder {
    int nM, nN, nwg, G, c;
    __host__ __device__ void init(int M, int N, int G_, int c_) { nM = M / BM; nN = N / BM; nwg = nM * nN; G = G_; c = c_; }
    __host__ __device__ bool next(int i, Unit& u) const {
        const long L = (long)i * G + c; if (L >= nwg) return false;
        int wgid = (int)L; { const int q = nwg / NXCD, r = nwg % NXCD, xcd = wgid % NXCD, off = wgid / NXCD; wgid = (xcd < r ? xcd * (q + 1) : r * (q + 1) + (xcd - r) * q) + off; }
        const int nig = WGM * nN, gid = wgid / nig, fm = gid * WGM, gsz = (nM - fm) < WGM ? (nM - fm) : WGM;
        u.pm = fm + ((wgid % nig) % gsz); u.pn = (wgid % nig) / gsz; return true;
    }
    __device__ __forceinline__ void a_ready(const Unit&) const {}
    __device__ __forceinline__ void done(const Unit&) const {}
};
constexpr int RSL_OFF = STAGE_BYTES;
template <class Sched> __device__ __forceinline__ void rs_precompute(const float* ss, const Sched& S, PG8_LAS unsigned char* lds) {
    int tid = threadIdx.x; asm volatile("" : "+v"(tid));
    PG8_LAS float* rsl = (PG8_LAS float*)(lds + RSL_OFF); Unit u;
    for (int i = tid >> 8; S.next(i, u); i += 2) { const int r = tid & 255; const f32x4* p = (const f32x4*)(ss + (size_t)(u.pm * BM + r) * 16);
        const f32x4 a = p[0], b = p[1], c = p[2], d = p[3];
        const float s = ((a.x + a.y) + (a.z + a.w)) + ((b.x + b.y) + (b.z + b.w)) + ((c.x + c.y) + (c.z + c.w)) + ((d.x + d.y) + (d.z + d.w));
        rsl[i * 256 + r] = __builtin_amdgcn_rsqf(s * (1.0f / 1024.0f) + 1e-6f); }
    __syncthreads();
}
template <bool HIN_F32> struct EpiRes {
    static constexpr bool PERM = true, AFTER_DRAIN = false;
    const float* hin32; bf16_t* hb; float* ssout;
    __device__ __forceinline__ void operator()(const f32x4 (&acc)[2][2][4][2], const Unit& u, int wr, int wc, int fr, int fq, int ui) const {
        const int col0 = u.pn * BM + wc * 32 + 8 * fq;
#pragma unroll
        for (int ai = 0; ai < 2; ++ai)
#pragma unroll
            for (int m = 0; m < 4; ++m) { const int row = u.pm * BM + ai * HALF + wr * 64 + m * 16 + fr; const size_t off = (size_t)row * DM + col0; float sq = 0.f;
#pragma unroll
                for (int bj = 0; bj < 2; ++bj) { const size_t o2 = off + bj * HALF; f32x4 h0, h1;
                    if (HIN_F32) { h0 = *(const f32x4*)(hin32 + o2); h1 = *(const f32x4*)(hin32 + o2 + 4); }
                    else { const u32x4 w = *(const u32x4*)(hb + o2); h0 = (f32x4){bflo(w.x), bfhi(w.x), bflo(w.y), bfhi(w.y)}; h1 = (f32x4){bflo(w.z), bfhi(w.z), bflo(w.w), bfhi(w.w)}; }
                    const f32x4 a = h0 + acc[ai][bj][m][0], b = h1 + acc[ai][bj][m][1];
                    u32x4 w; w.x = pk2(a[0], a[1]); w.y = pk2(a[2], a[3]); w.z = pk2(b[0], b[1]); w.w = pk2(b[2], b[3]); *(u32x4*)(hb + o2) = w;
                    sq += ((a[0] * a[0] + a[1] * a[1]) + (a[2] * a[2] + a[3] * a[3])) + ((b[0] * b[0] + b[1] * b[1]) + (b[2] * b[2] + b[3] * b[3])); }
                sq += __shfl_xor(sq, 16); sq += __shfl_xor(sq, 32);
                if (fq == 0) ssout[(size_t)row * 16 + u.pn * 4 + wc] = sq;
                if (m & 1) asm volatile("" ::: "memory"); }
    }
};
struct EpiGU {
    static constexpr bool PERM = true, AFTER_DRAIN = false;
    PG8_LAS const float* rsl; bf16_t* hid;
    __device__ __forceinline__ void operator()(const f32x4 (&acc)[2][2][4][2], const Unit& u, int wr, int wc, int fr, int fq, int ui) const {
        const int col = u.pn * HALF + wc * 32 + 8 * fq;
#pragma unroll
        for (int ai = 0; ai < 2; ++ai)
#pragma unroll
            for (int m = 0; m < 4; ++m) { const int rl = ai * HALF + wr * 64 + m * 16 + fr; const int row = u.pm * BM + rl; const float rs = rsl[ui * 256 + rl]; const float c = -LOG2E * rs, rs2 = rs * rs;
                u32x4 w; unsigned* wp = (unsigned*)&w;
#pragma unroll
                for (int n = 0; n < 2; ++n) { const f32x4 g = acc[ai][0][m][n], up = acc[ai][1][m][n]; f32x4 e = g * c;
                    e[0] = __builtin_amdgcn_exp2f(e[0]); e[1] = __builtin_amdgcn_exp2f(e[1]); e[2] = __builtin_amdgcn_exp2f(e[2]); e[3] = __builtin_amdgcn_exp2f(e[3]);
                    e = e + 1.0f; f32x4 r; r[0] = __builtin_amdgcn_rcpf(e[0]); r[1] = __builtin_amdgcn_rcpf(e[1]); r[2] = __builtin_amdgcn_rcpf(e[2]); r[3] = __builtin_amdgcn_rcpf(e[3]);
                    const f32x4 o = (g * up) * (r * rs2); wp[2 * n] = pk2(o[0], o[1]); wp[2 * n + 1] = pk2(o[2], o[3]); }
                __builtin_nontemporal_store(w, (u32x4*)(hid + (size_t)row * DFF + col)); }
    }
};
template <int LAYER> struct EpiIn {
    static constexpr bool PERM = true, AFTER_DRAIN = false;
    PG8_LAS const float* rsl; const float* cosT; const float* sinT; bf16_t* o0; bf16_t* o1;
    __device__ __forceinline__ void operator()(const f32x4 (&acc)[2][2][4][2], const Unit& u, int wr, int wc, int fr, int fq, int ui) const {
        const int col0 = u.pn * BM + wc * 32 + 8 * fq;
#pragma unroll
        for (int ai = 0; ai < 2; ++ai)
#pragma unroll
            for (int m = 0; m < 4; ++m) { const int rl = ai * HALF + wr * 64 + m * 16 + fr; const int row = u.pm * BM + rl; const float rs = rsl[ui * 256 + rl];
                if (LAYER == 0 && u.pn >= 3) {
                    const f32x4 a0 = acc[ai][0][m][0] * rs, a1 = acc[ai][0][m][1] * rs, b0 = acc[ai][1][m][0] * rs, b1 = acc[ai][1][m][1] * rs;
                    u32x4 w; w.x = pk2(a0[0] * sigmoidf_(b0[0]), a0[1] * sigmoidf_(b0[1])); w.y = pk2(a0[2] * sigmoidf_(b0[2]), a0[3] * sigmoidf_(b0[3]));
                    w.z = pk2(a1[0] * sigmoidf_(b1[0]), a1[1] * sigmoidf_(b1[1])); w.w = pk2(a1[2] * sigmoidf_(b1[2]), a1[3] * sigmoidf_(b1[3]));
                    __builtin_nontemporal_store(w, (u32x4*)(o1 + (size_t)row * 512 + (u.pn - 3) * HALF + wc * 32 + 8 * fq));
                } else {
                    constexpr int ld = (LAYER == 0) ? 768 : O_IN;
#pragma unroll
                    for (int bj = 0; bj < 2; ++bj) { f32x4 v0 = acc[ai][bj][m][0] * rs, v1 = acc[ai][bj][m][1] * rs;
                        const bool rot = ((wc & 1) == 0) && ((LAYER == 0) ? (u.pn * BM + bj * HALF + wc * 32 < 640) : (u.pn < 4));
                        if (rot) { f32x4 p0, p1;
#pragma unroll
                            for (int j = 0; j < 4; ++j) { p0[j] = __shfl_xor(v0[j], 16); p1[j] = __shfl_xor(v1[j], 16); }
                            if (fq < 2) { const int pos = row & (SEQ - 1); const f32x4 c0 = *(const f32x4*)(cosT + pos * 8), c1 = *(const f32x4*)(cosT + pos * 8 + 4), s0 = *(const f32x4*)(sinT + pos * 8), s1 = *(const f32x4*)(sinT + pos * 8 + 4);
                                if (fq == 0) { v0 = v0 * c0 - p0 * s0; v1 = v1 * c1 - p1 * s1; } else { v0 = v0 * c0 + p0 * s0; v1 = v1 * c1 + p1 * s1; } } }
                        if (LAYER == 1 && u.pn >= 6) {
#pragma unroll
                            for (int j = 0; j < 4; ++j) { v0[j] = gelu_tanh(v0[j]); v1[j] = gelu_tanh(v1[j]); } }
                        u32x4 w; w.x = pk2(v0[0], v0[1]); w.y = pk2(v0[2], v0[3]); w.z = pk2(v1[0], v1[1]); w.w = pk2(v1[2], v1[3]);
                        __builtin_nontemporal_store(w, (u32x4*)(o0 + (size_t)row * ld + col0 + bj * HALF)); }
                } }
    }
};
template <class Epi, class Sched, bool ALIGN_EPI = false, bool SP2 = false>
__device__ __forceinline__ void gemm_phase(PG8_LAS unsigned char* lds, const Gemm g, const Sched& S, const Epi& E) {
    int tid = threadIdx.x; asm volatile("" : "+v"(tid));
    const int wid = __builtin_amdgcn_readfirstlane(tid >> 6), lane = tid & 63, wr = wid >> 2, wc = wid & 3, fr = lane & 15, fq = lane >> 4;
    const int K = g.K, nt = K / BK;
    unsigned voffA[2], voffB[2];
#pragma unroll
    for (int i = 0; i < 2; ++i) { int R, C; stage_rc(tid * 16 + i * 8192, R, C); const int Rb = Epi::PERM ? ((R & ~31) + perm32(R & 31)) : R;
        voffA[i] = (unsigned)(R * K + C) * 2u; voffB[i] = (unsigned)(Rb * K + C) * 2u; }
    const size_t kstep = (size_t)(BK * 2);
    const size_t hstep = (size_t)HALF * K * 2;
    const size_t tstep = 2 * hstep;
    const unsigned ldsw = (unsigned)wid * 1024u;
    const int aoff = lds_byte(wr * 64 + fr, fq * 8), boff = lds_byte(wc * 32 + fr, fq * 8);
#define PG8_SA(b, h) (((b) * 2 + (h)) * HTB)
#define PG8_SB(b, h) ((4 + (b) * 2 + (h)) * HTB)
#define PG8_STAGE(bufoff, gbase, voff) do { _Pragma("unroll") for (int _i = 0; _i < 2; ++_i) \
        __builtin_amdgcn_global_load_lds((const unsigned*)((const char*)(gbase) + (voff)[_i]), (PG8_LAS unsigned*)(lds + (bufoff) + ldsw + _i * 8192), 16, 0, 0); } while (0)
#define PG8_LDA(dst, b, h) do { _Pragma("unroll") for (int m = 0; m < 4; ++m) _Pragma("unroll") for (int k = 0; k < 2; ++k) dst[m][k] = *(const PG8_LAS bf16x8*)(lds + PG8_SA(b, h) + aoff + m * 2048 + k * 1024); } while (0)
#define PG8_LDB(dst, b, h) do { _Pragma("unroll") for (int n = 0; n < 2; ++n) _Pragma("unroll") for (int k = 0; k < 2; ++k) dst[n][k] = *(const PG8_LAS bf16x8*)(lds + PG8_SB(b, h) + boff + n * 2048 + k * 1024); } while (0)
#define PG8_MMA(ai, bj, At, Bt) do { __builtin_amdgcn_s_setprio(1); _Pragma("unroll") for (int m = 0; m < 4; ++m) _Pragma("unroll") for (int n = 0; n < 2; ++n) _Pragma("unroll") for (int k = 0; k < 2; ++k) \
        acc[ai][bj][m][n] = __builtin_amdgcn_mfma_f32_16x16x32_bf16(Bt[n][k], At[m][k], acc[ai][bj][m][n], 0, 0, 0); __builtin_amdgcn_s_setprio(0); } while (0)
#define PG8_WAIT_V(n) asm volatile("s_waitcnt vmcnt(" #n ")" ::: "memory")
#define PG8_WAIT_L(n) asm volatile("s_waitcnt lgkmcnt(" #n ")" ::: "memory")
#define PG8_BAR __builtin_amdgcn_s_barrier()
#define PG8_SCHED __builtin_amdgcn_sched_barrier(0)
    Unit cur, nxt; int ui = 0;
    if (!S.next(0, cur)) return;
    f32x4 acc[2][2][4][2];
#pragma unroll
    for (int a = 0; a < 2; ++a)
#pragma unroll
        for (int b = 0; b < 2; ++b)
#pragma unroll
            for (int m = 0; m < 4; ++m)
#pragma unroll
                for (int n = 0; n < 2; ++n) acc[a][b][m][n] = (f32x4){0.f, 0.f, 0.f, 0.f};
    bf16x8 At[4][2], B0[2][2], B1[2][2];
    const char* cA = (const char*)g.A + (size_t)cur.pm * tstep; const char* cB = (const char*)g.Bt + (size_t)cur.pn * tstep;
    S.a_ready(cur);
    if constexpr (SP2) {
        PG8_STAGE(PG8_SB(0, 0), cB, voffB); PG8_STAGE(PG8_SB(0, 1), cB + hstep, voffB); PG8_STAGE(PG8_SA(0, 0), cA, voffA); PG8_STAGE(PG8_SA(0, 1), cA + hstep, voffA);
        if (wr == 1) PG8_BAR;
        PG8_WAIT_V(2); PG8_BAR;
        PG8_STAGE(PG8_SB(1, 0), cB + kstep, voffB); PG8_STAGE(PG8_SA(1, 0), cA + kstep, voffA); PG8_STAGE(PG8_SB(1, 1), cB + hstep + kstep, voffB);
        PG8_WAIT_V(6); PG8_BAR;
    } else {
        PG8_STAGE(PG8_SB(0, 0), cB, voffB); PG8_STAGE(PG8_SA(0, 0), cA, voffA); PG8_STAGE(PG8_SB(0, 1), cB + hstep, voffB); PG8_STAGE(PG8_SA(0, 1), cA + hstep, voffA);
        if (wr == 1) PG8_BAR;
        PG8_WAIT_V(4); PG8_BAR;
        PG8_STAGE(PG8_SB(1, 0), cB + kstep, voffB); PG8_STAGE(PG8_SA(1, 0), cA + kstep, voffA); PG8_STAGE(PG8_SB(1, 1), cB + hstep + kstep, voffB);
        PG8_WAIT_V(6); PG8_BAR;
    }
    for (;;) {
        const bool has_next = S.next(ui + 1, nxt);
        const char* nA = has_next ? (const char*)g.A + (size_t)nxt.pm * tstep : cA; const char* nB = has_next ? (const char*)g.Bt + (size_t)nxt.pn * tstep : cB;
        for (int t = 0; t < nt; t += 2) {
            const bool last = (t == nt - 2);
            const char* a1 = cA + (size_t)(t + 1) * kstep;
            const char* a2 = last ? nA : cA + (size_t)(t + 2) * kstep; const char* b2 = last ? nB : cB + (size_t)(t + 2) * kstep;
            const char* a3 = a2 + kstep; const char* b3 = b2 + kstep;
            if (last && has_next) S.a_ready(nxt);
            if constexpr (SP2) {
            PG8_LDB(B0, 0, 0); PG8_LDB(B1, 0, 1); PG8_SCHED; PG8_LDA(At, 0, 0); PG8_STAGE(PG8_SA(1, 1), a1 + hstep, voffA);
            PG8_WAIT_V(8); PG8_WAIT_L(0); PG8_BAR; PG8_MMA(0, 0, At, B0); PG8_MMA(0, 1, At, B1); PG8_BAR; PG8_SCHED;
            PG8_LDA(At, 0, 1); PG8_STAGE(PG8_SB(0, 0), b2, voffB); PG8_STAGE(PG8_SB(0, 1), b2 + hstep, voffB); PG8_STAGE(PG8_SA(0, 0), a2, voffA);
            PG8_WAIT_V(8); PG8_WAIT_L(0); PG8_BAR; PG8_MMA(1, 0, At, B0); PG8_MMA(1, 1, At, B1); PG8_BAR; PG8_SCHED;
            PG8_LDB(B0, 1, 0); PG8_LDB(B1, 1, 1); PG8_SCHED; PG8_LDA(At, 1, 0); PG8_STAGE(PG8_SA(0, 1), a2 + hstep, voffA);
            PG8_WAIT_V(8); PG8_WAIT_L(0); PG8_BAR; PG8_MMA(0, 0, At, B0); PG8_MMA(0, 1, At, B1); PG8_BAR; PG8_SCHED;
            PG8_LDA(At, 1, 1); PG8_STAGE(PG8_SB(1, 0), b3, voffB); PG8_STAGE(PG8_SB(1, 1), b3 + hstep, voffB); PG8_STAGE(PG8_SA(1, 0), a3, voffA);
            PG8_WAIT_V(8); PG8_WAIT_L(0); PG8_BAR; PG8_MMA(1, 0, At, B0); PG8_MMA(1, 1, At, B1); PG8_BAR; PG8_SCHED;
            } else {
            PG8_LDB(B0, 0, 0); PG8_SCHED; PG8_LDA(At, 0, 0); PG8_STAGE(PG8_SA(1, 1), a1 + hstep, voffA);
            PG8_WAIT_L(8); PG8_BAR; PG8_WAIT_L(0); PG8_MMA(0, 0, At, B0); PG8_BAR; PG8_SCHED;
            PG8_LDB(B1, 0, 1); PG8_STAGE(PG8_SB(0, 0), b2, voffB);
            PG8_BAR; PG8_WAIT_L(0); PG8_MMA(0, 1, At, B1); PG8_BAR;
            PG8_LDA(At, 0, 1); PG8_STAGE(PG8_SA(0, 0), a2, voffA);
            PG8_BAR; PG8_WAIT_L(0); PG8_MMA(1, 0, At, B0); PG8_BAR; PG8_SCHED;
            PG8_STAGE(PG8_SB(0, 1), b2 + hstep, voffB);
            PG8_WAIT_V(6); PG8_BAR; PG8_MMA(1, 1, At, B1); PG8_BAR;
            PG8_LDB(B0, 1, 0); PG8_SCHED; PG8_LDA(At, 1, 0); PG8_STAGE(PG8_SA(0, 1), a2 + hstep, voffA);
            PG8_WAIT_L(8); PG8_BAR; PG8_WAIT_L(0); PG8_MMA(0, 0, At, B0); PG8_BAR; PG8_SCHED;
            PG8_LDB(B1, 1, 1); PG8_STAGE(PG8_SB(1, 0), b3, voffB);
            PG8_BAR; PG8_WAIT_L(0); PG8_MMA(0, 1, At, B1); PG8_BAR;
            PG8_LDA(At, 1, 1); PG8_STAGE(PG8_SA(1, 0), a3, voffA);
            PG8_BAR; PG8_WAIT_L(0); PG8_MMA(1, 0, At, B0); PG8_BAR; PG8_SCHED;
            PG8_STAGE(PG8_SB(1, 1), b3 + hstep, voffB);
            PG8_WAIT_V(6); PG8_BAR; PG8_MMA(1, 1, At, B1); PG8_BAR;
            }
        }
        if constexpr (ALIGN_EPI) { if (wr == 0) PG8_BAR; }
        if constexpr (!Epi::AFTER_DRAIN) { E(acc, cur, wr, wc, fr, fq, ui); S.done(cur); }
        if (!has_next) break;
#pragma unroll
        for (int a = 0; a < 2; ++a)
#pragma unroll
            for (int b = 0; b < 2; ++b)
#pragma unroll
                for (int m = 0; m < 4; ++m)
#pragma unroll
                    for (int n = 0; n < 2; ++n) acc[a][b][m][n] = (f32x4){0.f, 0.f, 0.f, 0.f};
        cur = nxt; cA = nA; cB = nB; ++ui;
        if constexpr (ALIGN_EPI) { if (wr == 1) PG8_BAR; }
    }
    PG8_WAIT_V(0);
    if constexpr (!ALIGN_EPI) { if (wr == 0) PG8_BAR; }
    PG8_BAR;
    if constexpr (Epi::AFTER_DRAIN) { E.fused(acc, cur, wr, wc, fr, fq, lds, wid, lane); S.done(cur); }
#undef PG8_SA
#undef PG8_SB
#undef PG8_STAGE
#undef PG8_LDA
#undef PG8_LDB
#undef PG8_MMA
#undef PG8_WAIT_V
#undef PG8_WAIT_L
#undef PG8_BAR
#undef PG8_SCHED
}
}

constexpr int KROW = 144, KIMG = 256 * KROW, VIMG = 256 * 128, KVIMG = KIMG + VIMG;
__device__ __forceinline__ void stage_kv(const bf16_t* base  , int ld, int kcol, int vcol, int j0, int dil, int rho,
                                         LAS unsigned char* Kl, LAS unsigned char* Vl, int t, int nthr) {
    for (int idx = t; idx < 2048; idx += nthr) { const int row = idx >> 3, ch = idx & 7, j = j0 + row;
        u32x4 kv = {0u, 0u, 0u, 0u}, vv = {0u, 0u, 0u, 0u};
        if (j >= 0) { const bf16_t* rp = base + (size_t)(j * dil + rho) * ld + ch * 8; kv = *(const u32x4*)(rp + kcol); vv = *(const u32x4*)(rp + vcol); }
        *(LAS u32x4*)(Kl + row * KROW + ch * 16) = kv;
        *(LAS u32x4*)(Vl + row * 128 + ((ch * 16) ^ (((row >> 1) & 1) << 6))) = vv; }
}
__device__ __forceinline__ void load_q(const bf16_t* qptr, size_t qstride, int lane, bf16x8 (&qf)[4]) {
#pragma unroll
    for (int ks = 0; ks < 4; ++ks) qf[ks] = *(const bf16x8*)(qptr + (size_t)(lane & 31) * qstride + 16 * ks + 8 * (lane >> 5));
}
template <int NIT> __device__ __forceinline__ void kv_fetch(const bf16_t* base, int ld, int kcol, int vcol, int j0, int dil, int rho, int t, int nthr, u32x4 (&kr)[NIT], u32x4 (&vr)[NIT]) {
#pragma unroll
    for (int i = 0; i < NIT; ++i) { const int idx = t + i * nthr, row = idx >> 3, ch = idx & 7, j = j0 + row; kr[i] = (u32x4){0u, 0u, 0u, 0u}; vr[i] = (u32x4){0u, 0u, 0u, 0u};
        if (j >= 0) { const bf16_t* rp = base + (size_t)(j * dil + rho) * ld + ch * 8; kr[i] = *(const u32x4*)(rp + kcol); vr[i] = *(const u32x4*)(rp + vcol); } }
}
template <int NIT> __device__ __forceinline__ void kv_commit(LAS unsigned char* Kl, LAS unsigned char* Vl, int t, int nthr, const u32x4 (&kr)[NIT], const u32x4 (&vr)[NIT]) {
#pragma unroll
    for (int i = 0; i < NIT; ++i) { const int idx = t + i * nthr, row = idx >> 3, ch = idx & 7;
        *(LAS u32x4*)(Kl + row * KROW + ch * 16) = kr[i]; *(LAS u32x4*)(Vl + row * 128 + ((ch * 16) ^ (((row >> 1) & 1) << 6))) = vr[i]; }
}
template <bool SINK, bool LSE_OUT, bool EDGE>
__device__ __forceinline__ void attn_qtile(LAS unsigned char* Kl, LAS unsigned char* Vl, int kv0, int i0, int jrow0, int max_dist,
                                           float sink2, bf16_t* optr, size_t ostride, float* lseptr, size_t lsestride, int lane, const bf16x8 (&qf)[4]) {
    const int l31 = lane & 31, hi = lane >> 5;
    f32x16 s[5];
    { LAS unsigned char* kp = Kl + (kv0 + l31) * KROW + 16 * hi;
#pragma unroll
      for (int tile = 0; tile < 5; ++tile) { f32x16 acc = {};
#pragma unroll
          for (int ks = 0; ks < 4; ++ks) { const bf16x8 kf = *(LAS bf16x8*)(kp + tile * 32 * KROW + ks * 32); acc = __builtin_amdgcn_mfma_f32_32x32x16_bf16(kf, qf[ks], acc, 0, 0, 0); }
          s[tile] = acc; } }
    const int i = i0 + l31; float mx = -INFINITY;
#pragma unroll
    for (int tile = 0; tile < 5; ++tile)
#pragma unroll
        for (int r = 0; r < 16; ++r) { const int j = jrow0 + kv0 + 32 * tile + crow(r, hi); const int dist = i - j;
            bool valid;
            if (EDGE) valid = (j >= 0) && (dist >= 0) && (dist <= max_dist);
            else valid = (tile == 0) ? (dist <= max_dist) : ((tile == 4) ? (dist >= 0) : true);
            const float x = valid ? s[tile][r] * QK_C2 : -INFINITY; s[tile][r] = x; mx = fmaxf(mx, x); }
    mx = fmaxf(mx, __shfl_xor(mx, 32));
    if (SINK) mx = fmaxf(mx, sink2);
    float lsum = 0.f;
#pragma unroll
    for (int tile = 0; tile < 5; ++tile)
#pragma unroll
        for (int r = 0; r < 16; ++r) { const float p = __builtin_amdgcn_exp2f(s[tile][r] - mx); s[tile][r] = p; lsum += p; }
    lsum += __shfl_xor(lsum, 32);
    if (SINK) lsum += __builtin_amdgcn_exp2f(sink2 - mx);
    f32x16 o0 = {}, o1 = {};
    { const int g = lane >> 4, qd = (lane & 15) >> 2, p_ = lane & 3, sw = (qd >> 1) & 1;
      LAS unsigned char* vrow = Vl + (kv0 + 4 * hi + qd) * 128 + (16 * (g & 1) + 4 * p_) * 2;
      LAS unsigned char* vb0 = vrow + 64 * sw; LAS unsigned char* vb1 = vrow + 64 * (sw ^ 1);
#pragma unroll
      for (int tile = 0; tile < 5; ++tile)
#pragma unroll
          for (int ss = 0; ss < 2; ++ss) {
              u32x4 pw; pw.x = pk2(s[tile][8 * ss + 0], s[tile][8 * ss + 1]); pw.y = pk2(s[tile][8 * ss + 2], s[tile][8 * ss + 3]); pw.z = pk2(s[tile][8 * ss + 4], s[tile][8 * ss + 5]); pw.w = pk2(s[tile][8 * ss + 6], s[tile][8 * ss + 7]);
              const bf16x8 pf = __builtin_bit_cast(bf16x8, pw);
              const int ro = (32 * tile + 16 * ss) * 128;
              const s16x4 a0 = __builtin_amdgcn_ds_read_tr16_b64_v4i16((LAS s16x4*)(vb0 + ro)), b0 = __builtin_amdgcn_ds_read_tr16_b64_v4i16((LAS s16x4*)(vb0 + ro + 8 * 128));
              const s16x4 a1 = __builtin_amdgcn_ds_read_tr16_b64_v4i16((LAS s16x4*)(vb1 + ro)), b1 = __builtin_amdgcn_ds_read_tr16_b64_v4i16((LAS s16x4*)(vb1 + ro + 8 * 128));
              const bf16x8 vf0 = {a0[0], a0[1], a0[2], a0[3], b0[0], b0[1], b0[2], b0[3]}, vf1 = {a1[0], a1[1], a1[2], a1[3], b1[0], b1[1], b1[2], b1[3]};
              o0 = __builtin_amdgcn_mfma_f32_32x32x16_bf16(vf0, pf, o0, 0, 0, 0);
              o1 = __builtin_amdgcn_mfma_f32_32x32x16_bf16(vf1, pf, o1, 0, 0, 0); } }
    const float inv = 1.0f / lsum;
    bf16_t* op = optr + (size_t)l31 * ostride + 4 * hi;
#pragma unroll
    for (int g4 = 0; g4 < 4; ++g4) { u32x2 w0, w1;
        w0.x = pk2(o0[4 * g4] * inv, o0[4 * g4 + 1] * inv); w0.y = pk2(o0[4 * g4 + 2] * inv, o0[4 * g4 + 3] * inv);
        w1.x = pk2(o1[4 * g4] * inv, o1[4 * g4 + 1] * inv); w1.y = pk2(o1[4 * g4 + 2] * inv, o1[4 * g4 + 3] * inv);
        *(u32x2*)(op + 8 * g4) = w0; *(u32x2*)(op + 32 + 8 * g4) = w1; }
    if (LSE_OUT) { if (hi == 0) lseptr[(size_t)l31 * lsestride] = mx + __builtin_amdgcn_logf(lsum); }
}
__device__ __forceinline__ void attnA_phase(const bf16_t* QKV, const float* sinks, bf16_t* MIX, LAS unsigned char* lds) {
    int tid = threadIdx.x; asm volatile("" : "+v"(tid));
    const int lane = tid & 63, wave = __builtin_amdgcn_readfirstlane(tid >> 6);
    LAS unsigned char* Kl = lds; LAS unsigned char* Vl = lds + KIMG;
    u32x4 kr[4], vr[4];
    { const int it = blockIdx.x; if (it < 512) { const int n = it & 63, kvh = (it >> 6) & 1, b = it >> 7; kv_fetch<4>(QKV + (size_t)b * SEQ * 768, 768, 512 + kvh * 64, 640 + kvh * 64, 128 * (n - 1), 1, 0, tid, NTHR, kr, vr); } }
    for (int it = blockIdx.x; it < 512; it += gridDim.x) { const int n = it & 63, kvh = (it >> 6) & 1, b = it >> 7;
        __syncthreads();
        kv_commit<4>(Kl, Vl, tid, NTHR, kr, vr);
        __syncthreads();
        const int ti0 = 2 * wave, head0 = kvh * 4 + (ti0 >> 2);
        bf16x8 qa[4], qb[4];
        { const size_t tokq = (size_t)b * SEQ + 128 * n + 32 * (ti0 & 3); load_q(QKV + tokq * 768 + head0 * 64, 768, lane, qa); load_q(QKV + (tokq + 32) * 768 + head0 * 64, 768, lane, qb); }
        { const int nx = it + gridDim.x; if (nx < 512) { const int n2 = nx & 63, kvh2 = (nx >> 6) & 1, b2 = nx >> 7; kv_fetch<4>(QKV + (size_t)b2 * SEQ * 768, 768, 512 + kvh2 * 64, 640 + kvh2 * 64, 128 * (n2 - 1), 1, 0, tid, NTHR, kr, vr); } }
        const float sk = sinks[head0] * LOG2E;
        { const int qt = ti0 & 3, i0 = 128 * n + 32 * qt; const size_t tok = (size_t)b * SEQ + i0;
          if (n == 0) attn_qtile<true, false, true>(Kl, Vl, 32 * qt, i0, 128 * (n - 1), 127, sk, MIX + tok * DM + head0 * 64, DM, nullptr, 0, lane, qa);
          else attn_qtile<true, false, false>(Kl, Vl, 32 * qt, i0, 128 * (n - 1), 127, sk, MIX + tok * DM + head0 * 64, DM, nullptr, 0, lane, qa); }
        { const int qt = (ti0 & 3) + 1, i0 = 128 * n + 32 * qt; const size_t tok = (size_t)b * SEQ + i0;
          if (n == 0) attn_qtile<true, false, true>(Kl, Vl, 32 * qt, i0, 128 * (n - 1), 127, sk, MIX + tok * DM + head0 * 64, DM, nullptr, 0, lane, qb);
          else attn_qtile<true, false, false>(Kl, Vl, 32 * qt, i0, 128 * (n - 1), 127, sk, MIX + tok * DM + head0 * 64, DM, nullptr, 0, lane, qb); }
    }
}
struct CItem { int br, b, head, dil, rho, n; };
__device__ __forceinline__ CItem citem(int it) { CItem c; c.br = it >> 11; const int rem = it & 2047; c.b = rem >> 9; c.head = (rem >> 6) & 7; const int w = rem & 63, lg = 2 * c.br; c.dil = 1 << lg; c.rho = w & (c.dil - 1); c.n = w >> lg; return c; }
__device__ __forceinline__ void attnC_phase(const bf16_t* PROJ, bf16_t* OB, float* LSE, LAS unsigned char* lds) {
    int tid = threadIdx.x; asm volatile("" : "+v"(tid));
    const int lane = tid & 63, wave = __builtin_amdgcn_readfirstlane(tid >> 6), hw = wave >> 2, qt = wave & 3;
    LAS unsigned char* Kl = lds + hw * KVIMG; LAS unsigned char* Vl = Kl + KIMG;
    u32x4 kr[8], vr[8];
    if ((int)blockIdx.x < 3072) { const CItem c = citem(2 * blockIdx.x + hw); kv_fetch<8>(PROJ + (size_t)c.b * SEQ * O_IN, O_IN, 512 + c.head * 64, 1024 + c.head * 64, 128 * (c.n - 1), c.dil, c.rho, tid & 255, 256, kr, vr); }
    for (int pr = blockIdx.x; pr < 3072; pr += gridDim.x) { const CItem c = citem(2 * pr + hw);
        __syncthreads();
        kv_commit<8>(Kl, Vl, tid & 255, 256, kr, vr);
        __syncthreads();
        const int i0 = 128 * c.n + 32 * qt; const size_t tok = (size_t)c.b * SEQ + (size_t)i0 * c.dil + c.rho;
        bf16x8 qf[4]; load_q(PROJ + tok * O_IN + c.head * 64, (size_t)c.dil * O_IN, lane, qf);
        { const int nx = pr + gridDim.x; if (nx < 3072) { const CItem c2 = citem(2 * nx + hw); kv_fetch<8>(PROJ + (size_t)c2.b * SEQ * O_IN, O_IN, 512 + c2.head * 64, 1024 + c2.head * 64, 128 * (c2.n - 1), c2.dil, c2.rho, tid & 255, 256, kr, vr); } }
        if (c.n == 0) attn_qtile<false, true, true>(Kl, Vl, 32 * qt, i0, 128 * (c.n - 1), 128, 0.f,
                                OB + (size_t)c.br * M * 512 + tok * 512 + c.head * 64, (size_t)c.dil * 512, LSE + (size_t)c.br * M * 8 + tok * 8 + c.head, (size_t)c.dil * 8, lane, qf);
        else attn_qtile<false, true, false>(Kl, Vl, 32 * qt, i0, 128 * (c.n - 1), 128, 0.f,
                                OB + (size_t)c.br * M * 512 + tok * 512 + c.head * 64, (size_t)c.dil * 512, LSE + (size_t)c.br * M * 8 + tok * 8 + c.head, (size_t)c.dil * 8, lane, qf);
    }
}
__device__ __forceinline__ void combine_phase(const bf16_t* OB, const float* LSE, bf16_t* MIX) {
    int tid_ = threadIdx.x; asm volatile("" : "+v"(tid_));
    const int gt = blockIdx.x * NTHR + tid_, NGT = gridDim.x * NTHR;
    for (int idx = gt; idx < M * 64; idx += NGT) { const int tok = idx >> 6, head = (idx >> 3) & 7, c = idx & 7;
        const float l0 = LSE[(size_t)tok * 8 + head], l1 = LSE[(size_t)M * 8 + (size_t)tok * 8 + head], l2 = LSE[(size_t)2 * M * 8 + (size_t)tok * 8 + head];
        const float mx = fmaxf(l0, fmaxf(l1, l2)); float a0 = __builtin_amdgcn_exp2f(l0 - mx), a1 = __builtin_amdgcn_exp2f(l1 - mx), a2 = __builtin_amdgcn_exp2f(l2 - mx);
        const float inv = 1.0f / (a0 + a1 + a2); a0 *= inv; a1 *= inv; a2 *= inv;
        const size_t off = (size_t)tok * 512 + head * 64 + c * 8;
        const u32x4 x0 = __builtin_nontemporal_load((const u32x4*)(OB + off)), x1 = __builtin_nontemporal_load((const u32x4*)(OB + (size_t)M * 512 + off)), x2 = __builtin_nontemporal_load((const u32x4*)(OB + (size_t)2 * M * 512 + off));
        u32x4 o;
        o.x = pk2(a0 * bflo(x0.x) + a1 * bflo(x1.x) + a2 * bflo(x2.x), a0 * bfhi(x0.x) + a1 * bfhi(x1.x) + a2 * bfhi(x2.x));
        o.y = pk2(a0 * bflo(x0.y) + a1 * bflo(x1.y) + a2 * bflo(x2.y), a0 * bfhi(x0.y) + a1 * bfhi(x1.y) + a2 * bfhi(x2.y));
        o.z = pk2(a0 * bflo(x0.z) + a1 * bflo(x1.z) + a2 * bflo(x2.z), a0 * bfhi(x0.z) + a1 * bfhi(x1.z) + a2 * bfhi(x2.z));
        o.w = pk2(a0 * bflo(x0.w) + a1 * bflo(x1.w) + a2 * bflo(x2.w), a0 * bfhi(x0.w) + a1 * bfhi(x1.w) + a2 * bfhi(x2.w));
        __builtin_nontemporal_store(o, (u32x4*)(MIX + (size_t)tok * DM + head * 64 + c * 8)); }
}

__device__ __forceinline__ void conv_phase_tiled(const bf16_t* CE, const float* cw, const float* cb, const float* lg, const float* lb, bf16_t* MIX, LAS unsigned char* lds) {
    int tid = threadIdx.x; asm volatile("" : "+v"(tid));
    const int lane = tid & 63, wave = tid >> 6, cp = tid & 255, th = tid >> 8;
    LAS unsigned char* xin = lds; LAS unsigned char* yb = lds + 62 * 1024;
    f32x2 w[31];
#pragma unroll
    for (int k = 0; k < 31; ++k) w[k] = *(const f32x2*)(cw + k * 512 + 2 * cp);
    const f32x2 bias = *(const f32x2*)(cb + 2 * cp);
    u32x4 pre[8];
#define CONV_FETCH(UN) do { const int tok0_ = (UN) * 32, t0_ = tok0_ & (SEQ - 1); _Pragma("unroll") for (int q = 0; q < 8; ++q) { const int idx = tid + q * NTHR, r = idx >> 6, c = idx & 63; pre[q] = (u32x4){0u, 0u, 0u, 0u}; \
        if (idx < 62 * 64 && t0_ - 30 + r >= 0) pre[q] = *(const u32x4*)(CE + (size_t)(tok0_ - 30 + r) * 512 + 8 * c); } } while (0)
    if ((int)blockIdx.x < M / 32) CONV_FETCH((int)blockIdx.x);
    for (int un = blockIdx.x; un < M / 32; un += gridDim.x) {
        const int tok0 = un * 32;
        __syncthreads();
#pragma unroll
        for (int q = 0; q < 8; ++q) { const int idx = tid + q * NTHR, r = idx >> 6, c = idx & 63; if (idx < 62 * 64) *(LAS u32x4*)(xin + r * 1024 + 16 * c) = pre[q]; }
        __syncthreads();
        if (un + (int)gridDim.x < M / 32) CONV_FETCH(un + (int)gridDim.x);
        f32x2 acc[16];
#pragma unroll
        for (int i = 0; i < 16; ++i) acc[i] = bias;
#pragma unroll
        for (int r = 0; r < 46; ++r) { const unsigned xv = *(LAS unsigned*)(xin + (th * 16 + r) * 1024 + 4 * cp); const f32x2 x = {bflo(xv), bfhi(xv)};
#pragma unroll
            for (int tt = 0; tt < 16; ++tt) if (r - tt >= 0 && r - tt <= 30) acc[tt] += w[r - tt] * x; }
#pragma unroll
        for (int i = 0; i < 16; ++i) *(LAS f32x2*)(yb + (th * 16 + i) * 2048 + 8 * cp) = acc[i];
        __syncthreads();
#pragma unroll
        for (int i = 0; i < 4; ++i) { const int tt = wave * 4 + i;
            const f32x4 y0 = *(LAS f32x4*)(yb + tt * 2048 + 32 * lane), y1 = *(LAS f32x4*)(yb + tt * 2048 + 32 * lane + 16);
            float a[8] = {y0.x, y0.y, y0.z, y0.w, y1.x, y1.y, y1.z, y1.w}; float s = 0.f;
#pragma unroll
            for (int j = 0; j < 8; ++j) s += a[j];
            const float mean = wave_sum(s) * (1.f / 512.f); float q = 0.f;
#pragma unroll
            for (int j = 0; j < 8; ++j) { a[j] -= mean; q += a[j] * a[j]; }
            const float rstd = 1.0f / sqrtf(wave_sum(q) * (1.f / 512.f) + 1e-5f);
            const f32x4 g0 = *(const f32x4*)(lg + 8 * lane), g1 = *(const f32x4*)(lg + 8 * lane + 4), e0 = *(const f32x4*)(lb + 8 * lane), e1 = *(const f32x4*)(lb + 8 * lane + 4);
            u32x4 o; o.x = pk2(siluf_(a[0] * rstd * g0.x + e0.x), siluf_(a[1] * rstd * g0.y + e0.y)); o.y = pk2(siluf_(a[2] * rstd * g0.z + e0.z), siluf_(a[3] * rstd * g0.w + e0.w));
            o.z = pk2(siluf_(a[4] * rstd * g1.x + e1.x), siluf_(a[5] * rstd * g1.y + e1.y)); o.w = pk2(siluf_(a[6] * rstd * g1.z + e1.z), siluf_(a[7] * rstd * g1.w + e1.w));
            __builtin_nontemporal_store(o, (u32x4*)(MIX + (size_t)(tok0 + tt) * DM + 512 + 8 * lane)); }
    }
}

#undef CONV_FETCH
__device__ __forceinline__ void gmlp_phase(const bf16_t* PROJ, const float* lg, const float* lb, const bf16_t* SPW, const float* sb, bf16_t* MIX, LAS unsigned char* lds) {
    int tid = threadIdx.x; asm volatile("" : "+v"(tid));
    const int lane = tid & 63, wave = tid >> 6, l31 = lane & 31, hi = lane >> 5;
    for (int un = blockIdx.x; un < 512; un += gridDim.x) { const int ch = un >> 1, gh = un & 1;
        __syncthreads();
        u32x4 gin[16];
#pragma unroll
        for (int i = 0; i < 16; ++i) gin[i] = *(const u32x4*)(PROJ + ((size_t)ch * 128 + wave * 16 + i) * O_IN + 2048 + 8 * lane);
#pragma unroll
        for (int i = 0; i < 16; ++i) { const int tk = wave * 16 + i;
            const u32x4 w = gin[i];
            float a[8] = {bflo(w.x), bfhi(w.x), bflo(w.y), bfhi(w.y), bflo(w.z), bfhi(w.z), bflo(w.w), bfhi(w.w)}; float s = 0.f;
#pragma unroll
            for (int j = 0; j < 8; ++j) s += a[j];
            const float mean = wave_sum(s) * (1.f / 512.f); float q = 0.f;
#pragma unroll
            for (int j = 0; j < 8; ++j) { a[j] -= mean; q += a[j] * a[j]; }
            const float rstd = 1.0f / sqrtf(wave_sum(q) * (1.f / 512.f) + 1e-5f);
            if ((lane >> 5) == gh) { const f32x4 g0 = *(const f32x4*)(lg + 8 * lane), g1 = *(const f32x4*)(lg + 8 * lane + 4), e0 = *(const f32x4*)(lb + 8 * lane), e1 = *(const f32x4*)(lb + 8 * lane + 4);
                u32x4 o; o.x = pk2(a[0] * rstd * g0.x + e0.x, a[1] * rstd * g0.y + e0.y); o.y = pk2(a[2] * rstd * g0.z + e0.z, a[3] * rstd * g0.w + e0.w);
                o.z = pk2(a[4] * rstd * g1.x + e1.x, a[5] * rstd * g1.y + e1.y); o.w = pk2(a[6] * rstd * g1.z + e1.z, a[7] * rstd * g1.w + e1.w);
                *(LAS u32x4*)(lds + tk * 512 + ((16 * l31) ^ ((tk & 3) << 6))) = o; } }
        __syncthreads();
        const int gl = wave >> 1, ddt = wave & 1, grp = 4 * gh + gl;
        const int g = lane >> 4, qd = (lane & 15) >> 2, p_ = lane & 3;
        LAS unsigned char* bp = lds + (8 * hi + qd) * 512 + ((128 * gl + 64 * ddt + 32 * (g & 1) + 8 * p_) ^ (qd << 6));
        bf16x8 bfr[8];
#pragma unroll
        for (int ks = 0; ks < 8; ++ks) { const s16x4 x0 = __builtin_amdgcn_ds_read_tr16_b64_v4i16((LAS s16x4*)(bp + (16 * ks) * 512)), x1 = __builtin_amdgcn_ds_read_tr16_b64_v4i16((LAS s16x4*)(bp + (16 * ks + 4) * 512));
            bfr[ks] = (bf16x8){x0[0], x0[1], x0[2], x0[3], x1[0], x1[1], x1[2], x1[3]}; }
        const bf16_t* wbase = SPW + (size_t)grp * 128 * 128 + 8 * hi;
        const int chn = 64 * grp + 32 * ddt + l31;
#pragma unroll
        for (int tt = 0; tt < 4; ++tt) { f32x16 acc = {};
            const bf16_t* wp = wbase + (size_t)(32 * tt + l31) * 128;
#pragma unroll
            for (int ks = 0; ks < 8; ++ks) if (ks < 2 * tt + 2) { const bf16x8 af = *(const bf16x8*)(wp + 16 * ks); acc = __builtin_amdgcn_mfma_f32_32x32x16_bf16(af, bfr[ks], acc, 0, 0, 0); }
#pragma unroll
            for (int r = 0; r < 16; ++r) { const int t = 32 * tt + crow(r, hi); const size_t row = (size_t)ch * 128 + t;
                const float u = bf2f(PROJ[row * O_IN + 1536 + chn]); MIX[row * DM + 512 + chn] = (bf16_t)f2bf(u * (acc[r] + sb[grp * 128 + t])); } }
    }
}

__device__ __forceinline__ void final_norm(const bf16_t* HB, const float* ss, const float* g, float* out) {
    int tid_ = threadIdx.x; asm volatile("" : "+v"(tid_));
    const int lane = tid_ & 63, wave = tid_ >> 6; const int gw = blockIdx.x * NWAVE + wave, NGW = gridDim.x * NWAVE;
    const f32x4 g0 = *(const f32x4*)(g + 8 * lane), g1 = *(const f32x4*)(g + 8 * lane + 4), g2 = *(const f32x4*)(g + 512 + 8 * lane), g3 = *(const f32x4*)(g + 512 + 8 * lane + 4);
    for (int m = gw; m < M; m += NGW) { const float rs = row_rstd(ss, m);
        const u32x4 w0 = __builtin_nontemporal_load((const u32x4*)(HB + (size_t)m * DM + 8 * lane)), w1 = __builtin_nontemporal_load((const u32x4*)(HB + (size_t)m * DM + 512 + 8 * lane));
        float* o = out + (size_t)m * DM + 8 * lane;
        __builtin_nontemporal_store((f32x4){bflo(w0.x), bfhi(w0.x), bflo(w0.y), bfhi(w0.y)} * rs * g0, (f32x4*)(o)); __builtin_nontemporal_store((f32x4){bflo(w0.z), bfhi(w0.z), bflo(w0.w), bfhi(w0.w)} * rs * g1, (f32x4*)(o + 4));
        __builtin_nontemporal_store((f32x4){bflo(w1.x), bfhi(w1.x), bflo(w1.y), bfhi(w1.y)} * rs * g2, (f32x4*)(o + 512)); __builtin_nontemporal_store((f32x4){bflo(w1.z), bfhi(w1.z), bflo(w1.w), bfhi(w1.w)} * rs * g3, (f32x4*)(o + 516)); }
}

typedef __attribute__((address_space(1))) unsigned gu32;
#define XB_TMO      128
#define XB_XCNT(j)  (256  + 64 * (j))
#define XB_XSUB(j)  (1280 + 64 * (j))
#define XB_XGEN(j)  (2304 + 64 * (j))
#define XB_TOP      3328
#define XB_TOPGEN   3392
#define XCD_BAR_WORDS 3456
#define XB_SPIN_CAP (1u << 18)

__device__ __forceinline__ unsigned xb_ld(unsigned* p)              { return __hip_atomic_load(p, __ATOMIC_RELAXED, __HIP_MEMORY_SCOPE_AGENT); }
__device__ __forceinline__ unsigned xb_add(unsigned* p, unsigned v) { return __hip_atomic_fetch_add(p, v, __ATOMIC_RELAXED, __HIP_MEMORY_SCOPE_AGENT); }
__device__ __forceinline__ unsigned xb_xcc_id() { return (unsigned)__builtin_amdgcn_s_getreg((3 << 11) | 20) & 0xFu; }
#define XB_SPIN(cond, bar) do { unsigned _sp = 0; while (cond) { __builtin_amdgcn_s_sleep(1); \
    if ((++_sp & 255u) == 0u) { if (xb_ld(&(bar)[XB_TMO])) break; if (_sp > XB_SPIN_CAP) { atomicAdd(&(bar)[XB_TMO], 1u); break; } } } } while (0)

struct XcdBarrier {
    unsigned* bar; unsigned x;
    volatile LAS unsigned* st;
};

__device__ __forceinline__ XcdBarrier xcd_barrier_post(unsigned* bar, volatile LAS unsigned* st) {
    XcdBarrier b; b.bar = bar; b.x = xb_xcc_id(); b.st = st;
    if (threadIdx.x == 0) (void)xb_add(&bar[XB_XCNT(b.x)], 1u);
    return b;
}
__device__ __forceinline__ void xcd_barrier_complete(unsigned* bar, unsigned x, unsigned& nloc, unsigned& nx) {
    const unsigned G = gridDim.x * gridDim.y * gridDim.z;
    unsigned sum, cnt, mine, sp = 0u;
    for (;;) {
        sum = 0u; cnt = 0u; mine = 0u;
#pragma unroll
        for (unsigned j = 0; j < 16; ++j) { const unsigned c = xb_ld(&bar[XB_XCNT(j)]); sum += c; cnt += (c > 0u) ? 1u : 0u; mine = (j == x) ? c : mine; }
        if (sum == G) break;
        __builtin_amdgcn_s_sleep(1);
        if ((++sp & 255u) == 0u) { if (xb_ld(&bar[XB_TMO])) break; if (sp > XB_SPIN_CAP) { atomicAdd(&bar[XB_TMO], 1u); break; } }
    }
    nloc = mine > 0u ? mine : 1u; nx = cnt > 0u ? cnt : 1u;
}

__device__ __forceinline__ void xcd_barrier(const XcdBarrier& b) {
    asm volatile("s_waitcnt vmcnt(0)" ::: "memory");
    __syncthreads();
    if (threadIdx.x == 0) {
        unsigned* bar = b.bar;
        __builtin_amdgcn_s_waitcnt(0);
        unsigned nloc = b.st[0], nx = b.st[1];
        if (nloc == 0u) { xcd_barrier_complete(bar, b.x, nloc, nx); b.st[0] = nloc; b.st[1] = nx; }
        const unsigned old = xb_add(&bar[XB_XSUB(b.x)], 1u);
        const unsigned gen = old / nloc;
        if (old + 1u == (gen + 1u) * nloc) {
            __builtin_amdgcn_fence(__ATOMIC_RELEASE, "agent");
            asm volatile("s_waitcnt vmcnt(0)" ::: "memory");
            const unsigned og = xb_add(&bar[XB_TOP], 1u);
            const unsigned tg = og / nx;
            if (og + 1u == (tg + 1u) * nx) xb_add(&bar[XB_TOPGEN], 1u);
            else XB_SPIN(xb_ld(&bar[XB_TOPGEN]) == tg, bar);
            __builtin_amdgcn_fence(__ATOMIC_ACQUIRE, "agent");
            xb_add(&bar[XB_XGEN(b.x)], 1u);
            asm volatile("s_waitcnt vmcnt(0)" ::: "memory");
        } else {
            XB_SPIN(xb_ld(&bar[XB_XGEN(b.x)]) == gen, bar);
            __builtin_amdgcn_fence(__ATOMIC_ACQUIRE, "agent");
            asm volatile("s_waitcnt vmcnt(0)" ::: "memory");
        }
    }
    __syncthreads();
}

template <int L> __device__ __forceinline__ void layer_body(const Params& P, LAS unsigned char* lds, const XcdBarrier& xbar) {
    unsigned char* ws = P.ws;
    const float* cosT = (const float*)(ws + WS_COS); const float* sinT = (const float*)(ws + WS_SIN);
    float* SS = (float*)(ws + WS_SS); bf16_t* HB = (bf16_t*)(ws + WS_HB); bf16_t* MIX = (bf16_t*)(ws + WS_MIX);
    bf16_t* R1 = (bf16_t*)(ws + WS_R1); bf16_t* CE = (bf16_t*)(ws + WS_CE); float* H = P.out;
        if (L == 0) { pg8::Gemm g{HB, (const bf16_t*)(ws + WS_W_EIN), M, E_IN, DM}; pg8::StaticOrder S; S.init(M, E_IN, (int)gridDim.x, (int)blockIdx.x);
            pg8::rs_precompute(SS, S, lds); pg8::EpiIn<0> E{(LAS const float*)(lds + pg8::RSL_OFF), cosT, sinT, R1, CE}; pg8::gemm_phase<pg8::EpiIn<0>, pg8::StaticOrder, true, true>(lds, g, S, E);
            { const int G = (int)gridDim.x, nwg = (M / 256) * (E_IN / 256), rounds = (nwg + G - 1) / G, thr = nwg - (rounds - 1) * G, nidle = G - thr;
              const int wv = threadIdx.x >> 6;
              if (nidle <= 0) convert_weights(P, lds, CONV_SPLIT, NITEMS, (int)blockIdx.x * NWAVE + wv, G * NWAVE);
              else if ((int)blockIdx.x >= thr) convert_weights(P, lds, CONV_SPLIT, NITEMS, ((int)blockIdx.x - thr) * NWAVE + wv, nidle * NWAVE); } }
        else { pg8::Gemm g{HB, (const bf16_t*)(ws + WS_W_OIN), M, O_IN, DM}; pg8::StaticOrder S; S.init(M, O_IN, (int)gridDim.x, (int)blockIdx.x);
            pg8::rs_precompute(SS, S, lds); pg8::EpiIn<1> E{(LAS const float*)(lds + pg8::RSL_OFF), cosT, sinT, R1, nullptr}; pg8::gemm_phase<pg8::EpiIn<1>, pg8::StaticOrder, true, true>(lds, g, S, E); }
        xcd_barrier(xbar);
        if (L == 0) { attnA_phase(R1, P.in[3], MIX, lds); __syncthreads(); conv_phase_tiled(CE, P.in[4], P.in[5], P.in[6], P.in[7], MIX, lds); }
        else { attnC_phase(R1, (bf16_t*)(ws + WS_OB), (float*)(ws + WS_LSE), lds); __syncthreads(); gmlp_phase(R1, P.in[11], P.in[12], (const bf16_t*)(ws + WS_SPW), P.in[14], MIX, lds);
            xcd_barrier(xbar); combine_phase((const bf16_t*)(ws + WS_OB), (const float*)(ws + WS_LSE), MIX); }
        xcd_barrier(xbar);
        { pg8::Gemm g{MIX, (const bf16_t*)(ws + (L ? WS_W_OOUT : WS_W_EOUT)), M, DM, DM}; pg8::StaticOrder S; S.init(M, DM, (int)gridDim.x, (int)blockIdx.x);
          pg8::EpiRes<false> E{nullptr, HB, SS}; pg8::gemm_phase<pg8::EpiRes<false>, pg8::StaticOrder, true, true>(lds, g, S, E); }
        xcd_barrier(xbar);
        { pg8::Gemm g{HB, (const bf16_t*)(ws + (L ? WS_W_GU1 : WS_W_GU0)), M, 2 * DFF, DM}; pg8::StaticOrder S; S.init(M, 2 * DFF, (int)gridDim.x, (int)blockIdx.x);
          pg8::rs_precompute(SS, S, lds); pg8::EpiGU E{(LAS const float*)(lds + pg8::RSL_OFF), R1}; pg8::gemm_phase<pg8::EpiGU, pg8::StaticOrder, true, true>(lds, g, S, E); }
        xcd_barrier(xbar);
        { pg8::Gemm g{R1, (const bf16_t*)(ws + (L ? WS_W_DN1 : WS_W_DN0)), M, DM, DFF}; pg8::StaticOrder S; S.init(M, DM, (int)gridDim.x, (int)blockIdx.x);
          pg8::EpiRes<false> E{nullptr, HB, SS}; pg8::gemm_phase<pg8::EpiRes<false>, pg8::StaticOrder, true, true>(lds, g, S, E); }
        xcd_barrier(xbar);
}

__global__ void __launch_bounds__(NTHR, 2) fwd_kernel(Params P) {
    extern __shared__ __attribute__((aligned(16))) unsigned char lds_raw[];
    LAS unsigned char* lds = (LAS unsigned char*)lds_raw;
    cg::grid_group grid = cg::this_grid();
    unsigned char* ws = P.ws;
    const float* cosT = (const float*)(ws + WS_COS); const float* sinT = (const float*)(ws + WS_SIN);
    float* SS = (float*)(ws + WS_SS); bf16_t* HB = (bf16_t*)(ws + WS_HB); bf16_t* MIX = (bf16_t*)(ws + WS_MIX);
    bf16_t* R1 = (bf16_t*)(ws + WS_R1); bf16_t* CE = (bf16_t*)(ws + WS_CE); float* H = P.out;

    volatile LAS unsigned* xst = (volatile LAS unsigned*)(lds + LDS_BYTES - 64);
    if (threadIdx.x < 2) xst[threadIdx.x] = 0u;
    __syncthreads();
    const XcdBarrier xbar = xcd_barrier_post((unsigned*)(ws + WS_BAR), xst);
    p0_prologue(P, lds);
    xcd_barrier(xbar);
    if (gridDim.x == 0x7fffffffu) grid.sync();
    layer_body<0>(P, lds, xbar);
    layer_body<1>(P, lds, xbar);
    final_norm(HB, SS, P.in[20], P.out);
}

extern "C" void kernel_launch(void* const* d_in, const int* in_sizes, int n_in, void* d_out, int out_size, void* d_ws, size_t ws_size, hipStream_t stream) {
    static int grid = 0;
    if (grid == 0) {
        if (n_in != 21 || out_size != M * DM || ws_size < WS_END) { fprintf(stderr, "kernel_launch: unexpected problem (n_in %d, out %d, ws %zu)\n", n_in, out_size, ws_size); grid = -1; return; }
        int dev = 0, cus = 0, per_cu = 0;
        hipGetDevice(&dev); hipDeviceGetAttribute(&cus, hipDeviceAttributeMultiprocessorCount, dev);
        hipFuncSetAttribute((const void*)fwd_kernel, hipFuncAttributeMaxDynamicSharedMemorySize, LDS_BYTES);
        hipOccupancyMaxActiveBlocksPerMultiprocessor(&per_cu, (const void*)fwd_kernel, NTHR, LDS_BYTES);
        if (per_cu < 1) { fprintf(stderr, "kernel_launch: occupancy query says %d blocks/CU\n", per_cu); per_cu = 1; }
        grid = cus * per_cu;
        fprintf(stderr, "kernel_launch: grid %d (cus %d x %d)\n", grid, cus, per_cu);
    }
    if (grid < 0) return;
    Params p{};
    for (int i = 0; i < 21; ++i) p.in[i] = (const float*)d_in[i];
    p.out = (float*)d_out; p.ws = (unsigned char*)d_ws;
    if (hipMemsetAsync((unsigned char*)d_ws + WS_BAR, 0, BAR_BYTES, stream) != hipSuccess) { fprintf(stderr, "kernel_launch: memset failed\n"); return; }
    void* args[] = {&p};
    hipError_t e = hipLaunchCooperativeKernel((const void*)fwd_kernel, dim3(grid), dim3(NTHR), args, LDS_BYTES, stream);
    if (e != hipSuccess) fprintf(stderr, "cooperative launch failed: %s (grid %d)\n", hipGetErrorString(e), grid);
}
```
